# Optimizing an MI355X kernel written in HIP

```python
import jax, jax.numpy as jnp
from jax import lax
import numpy as np

D_MODEL = 2048
BATCH = 2
SEQ = 16384
DEPTH = 1

D_MIX = D_MODEL
D_CONV_A = D_MIX // 2
D_CONV_B = D_MIX - D_CONV_A
HEAD_DIM = 128
N_HEADS_A = D_CONV_A // HEAD_DIM
N_GROUPS_B = D_CONV_B // HEAD_DIM
KERNEL_A = 3
KERNEL_B = 31
D_IN_PROJ = 3 * D_CONV_A + 2 * D_CONV_B
N_GROUPS = 8
EXPERTS_PER_GROUP = 8
N_EXPERTS = N_GROUPS * EXPERTS_PER_GROUP
TOP_K = 2
D_EXPERT = D_MODEL // 2
BLOCK = 128
N_MOD = 6
EPS = 1e-6

kernel_name = "hybrid_shortconv_conformer_hmoe_block"


def rms_norm(x, g):
    xf = x.astype(jnp.float32)
    y = xf * lax.rsqrt(jnp.mean(xf * xf, axis=-1, keepdims=True) + EPS)
    return (y * g.astype(jnp.float32)).astype(x.dtype)


def layer_norm(x, g, b):
    xf = x.astype(jnp.float32)
    mu = jnp.mean(xf, axis=-1, keepdims=True)
    var = jnp.mean(jnp.square(xf - mu), axis=-1, keepdims=True)
    y = (xf - mu) * lax.rsqrt(var + EPS)
    return (y * g.astype(jnp.float32) + b.astype(jnp.float32)).astype(x.dtype)


def causal_dwconv(x, w):
    k, ch = w.shape
    return lax.conv_general_dilated(
        x, w[:, None, :].astype(x.dtype), window_strides=(1,), padding=[(k - 1, 0)],
        dimension_numbers=("NWC", "WIO", "NWC"), feature_group_count=ch)


def modulate(h, shift, scale):
    return h * (1.0 + scale[:, None, :]) + shift[:, None, :]


def token_mixer(h, w_in, conv_a, norm_a_out, conv_b, conv_b_bias, ln_b_gain, ln_b_bias, w_out):
    bsz, t, _ = h.shape
    proj = jnp.einsum("btd,de->bte", h, w_in)
    b_a, c_a, v_a, val_b, gate_b = jnp.split(
        proj, [D_CONV_A, 2 * D_CONV_A, 3 * D_CONV_A, 3 * D_CONV_A + D_CONV_B], axis=-1)
    y_a = b_a * causal_dwconv(c_a * v_a, conv_a)
    y_a = rms_norm(y_a.reshape(bsz, t, N_HEADS_A, HEAD_DIM),
                   norm_a_out.reshape(N_HEADS_A, HEAD_DIM)).reshape(bsz, t, D_CONV_A)
    u = val_b * jax.nn.sigmoid(gate_b)
    u = causal_dwconv(u, conv_b) + conv_b_bias
    y_b = jax.nn.silu(layer_norm(u, ln_b_gain, ln_b_bias))
    y = jnp.concatenate([y_a, y_b], axis=-1)
    return jnp.einsum("bte,ed->btd", y, w_out)


def hierarchical_moe(h, w_rg, b_rg, w_re, b_re, w_eg, w_eu, w_ed):
    n_tok, d = h.shape
    coarse = (h @ w_rg + b_rg).astype(jnp.float32)
    p_coarse = jax.nn.softmax(coarse, axis=-1)
    g_sel = jnp.argmax(coarse, axis=-1)
    p_g = jnp.take_along_axis(p_coarse, g_sel[:, None], axis=-1)
    fine_all = jnp.einsum("nd,gde->nge", h, w_re) + b_re
    fine = jnp.take_along_axis(fine_all, g_sel[:, None, None], axis=1)[:, 0].astype(jnp.float32)
    top_v, top_i = lax.top_k(fine, TOP_K)
    gate_w = p_g * jax.nn.softmax(top_v, axis=-1)
    expert = g_sel[:, None] * EXPERTS_PER_GROUP + top_i

    n_assign = n_tok * TOP_K
    flat_e = expert.reshape(-1).astype(jnp.int32)
    flat_tok = jnp.repeat(jnp.arange(n_tok, dtype=jnp.int32), TOP_K)
    flat_w = gate_w.reshape(-1).astype(h.dtype)
    order = jnp.argsort(flat_e)
    se = flat_e[order]
    counts = jnp.bincount(flat_e, length=N_EXPERTS).astype(jnp.int32)
    padded = (counts + BLOCK - 1) // BLOCK * BLOCK
    start = jnp.cumsum(counts) - counts
    pend = jnp.cumsum(padded)
    pstart = pend - padded
    dest = pstart[se] + (jnp.arange(n_assign, dtype=jnp.int32) - start[se])
    n_blocks = (n_assign + N_EXPERTS * (BLOCK - 1) + BLOCK - 1) // BLOCK
    cap = n_blocks * BLOCK
    buf_tok = jnp.full((cap,), n_tok, jnp.int32).at[dest].set(flat_tok[order])
    buf_w = jnp.zeros((cap,), h.dtype).at[dest].set(flat_w[order])
    block_start = jnp.arange(n_blocks, dtype=jnp.int32) * BLOCK
    block_e = jnp.minimum(jnp.searchsorted(pend, block_start, side="right"), N_EXPERTS - 1)
    h_pad = jnp.concatenate([h, jnp.zeros((1, d), h.dtype)], axis=0)

    def expert_block(args):
        tok, w, e = args
        xb = h_pad[tok]
        hid = jax.nn.silu(xb @ w_eg[e]) * (xb @ w_eu[e])
        return (hid @ w_ed[e]) * w[:, None]

    ys = lax.map(expert_block, (buf_tok.reshape(n_blocks, BLOCK),
                                buf_w.reshape(n_blocks, BLOCK), block_e))
    out = jax.ops.segment_sum(ys.reshape(cap, d), buf_tok, num_segments=n_tok + 1)
    return out[:n_tok]


def setup_inputs(seed: int = 0) -> dict:
    key = jax.random.key(seed)
    ks = jax.random.split(key, 24)
    nrm = jax.random.normal
    L, D = DEPTH, D_MODEL
    return {
        "x": nrm(ks[0], (BATCH, SEQ, D), jnp.float32),
        "c": nrm(ks[1], (BATCH, D), jnp.float32),
        "w_ada": nrm(ks[2], (L, D, N_MOD * D), jnp.float32) * (0.5 * D ** -0.5),
        "b_ada": nrm(ks[3], (L, N_MOD * D), jnp.float32) * 0.01,
        "norm_mix_pre": 1.0 + 0.02 * nrm(ks[4], (L, D), jnp.float32),
        "norm_mix_post": 1.0 + 0.02 * nrm(ks[5], (L, D), jnp.float32),
        "w_in": nrm(ks[6], (L, D, D_IN_PROJ), jnp.float32) * D ** -0.5,
        "conv_a": nrm(ks[7], (L, KERNEL_A, D_CONV_A), jnp.float32) * KERNEL_A ** -0.5,
        "norm_a_out": 1.0 + 0.02 * nrm(ks[8], (L, D_CONV_A), jnp.float32),
        "conv_b": nrm(ks[9], (L, KERNEL_B, D_CONV_B), jnp.float32) * KERNEL_B ** -0.5,
        "conv_b_bias": nrm(ks[10], (L, D_CONV_B), jnp.float32) * 0.01,
        "ln_b_gain": 1.0 + 0.02 * nrm(ks[11], (L, D_CONV_B), jnp.float32),
        "ln_b_bias": nrm(ks[12], (L, D_CONV_B), jnp.float32) * 0.01,
        "w_out": nrm(ks[13], (L, D_MIX, D), jnp.float32) * D_MIX ** -0.5,
        "norm_moe_pre": 1.0 + 0.02 * nrm(ks[14], (L, D), jnp.float32),
        "norm_moe_post": 1.0 + 0.02 * nrm(ks[15], (L, D), jnp.float32),
        "w_router_group": nrm(ks[16], (L, D, N_GROUPS), jnp.float32) * D ** -0.5,
        "b_router_group": nrm(ks[17], (L, N_GROUPS), jnp.float32) * 0.01,
        "w_router_expert": nrm(ks[18], (L, N_GROUPS, D, EXPERTS_PER_GROUP), jnp.float32) * D ** -0.5,
        "b_router_expert": nrm(ks[19], (L, N_GROUPS, EXPERTS_PER_GROUP), jnp.float32) * 0.01,
        "w_expert_gate": nrm(ks[20], (L, N_EXPERTS, D, D_EXPERT), jnp.float32) * D ** -0.5,
        "w_expert_up": nrm(ks[21], (L, N_EXPERTS, D, D_EXPERT), jnp.float32) * D ** -0.5,
        "w_expert_down": nrm(ks[22], (L, N_EXPERTS, D_EXPERT, D), jnp.float32) * D_EXPERT ** -0.5,
    }


def reference(x, c, w_ada, b_ada, norm_mix_pre, norm_mix_post, w_in, conv_a, norm_a_out,
              conv_b, conv_b_bias, ln_b_gain, ln_b_bias, w_out, norm_moe_pre, norm_moe_post,
              w_router_group, b_router_group, w_router_expert, b_router_expert,
              w_expert_gate, w_expert_up, w_expert_down):
    bsz, t, d = x.shape
    c_act = jax.nn.silu(c)
    for l in range(DEPTH):
        mod = c_act @ w_ada[l] + b_ada[l]
        shift1, scale1, gate1, shift2, scale2, gate2 = jnp.split(mod, N_MOD, axis=-1)
        h = modulate(rms_norm(x, norm_mix_pre[l]), shift1, scale1)
        y = token_mixer(h, w_in[l], conv_a[l], norm_a_out[l], conv_b[l], conv_b_bias[l],
                        ln_b_gain[l], ln_b_bias[l], w_out[l])
        x = x + gate1[:, None, :] * rms_norm(y, norm_mix_post[l])
        h = modulate(rms_norm(x, norm_moe_pre[l]), shift2, scale2)
        y = hierarchical_moe(h.reshape(bsz * t, d), w_router_group[l], b_router_group[l],
                             w_router_expert[l], b_router_expert[l], w_expert_gate[l],
                             w_expert_up[l], w_expert_down[l]).reshape(bsz, t, d)
        x = x + gate2[:, None, :] * rms_norm(y, norm_moe_post[l])
    return x
```

```cpp
#include <hip/hip_runtime.h>
#include <cstdio>
#include <cstdint>
namespace pg8 {
#define PG8_LAS __attribute__((address_space(3)))
typedef unsigned short bf16_t;
typedef short bf16x8 __attribute__((ext_vector_type(8)));
typedef float f32x4 __attribute__((ext_vector_type(4)));
typedef unsigned u32x4 __attribute__((ext_vector_type(4)));
constexpr int BM = 256, BK = 64, HALF = 128, HTB = HALF * BK * 2  , STAGE_BYTES = 8 * HTB, NXCD = 8, WGM = 8;

__host__ __device__ __forceinline__ int lds_byte(int r, int c) { const int st = (r >> 4) * 2 + (c >> 5), rr = r & 15, cc = c & 31, ob = rr * 64 + cc * 2; return st * 1024 + (ob ^ (((ob >> 9) & 1) << 5)); }
__host__ __device__ __forceinline__ void stage_rc(int b, int& R, int& C) { const int st = b / 1024, sb = b % 1024, swz = sb ^ (((sb >> 9) & 1) << 5); R = (st >> 1) * 16 + swz / 64; C = (st & 1) * 32 + (swz % 64) / 2; }
__host__ __device__ __forceinline__ int perm32(int rho) { const int n = rho >> 4, i = rho & 15; return 8 * (i >> 2) + 4 * n + (i & 3); }

struct Unit { int pm, pn; };
struct Gemm { const bf16_t* A; const bf16_t* Bt; int M, N, K; };

struct StaticOrder {
    int nM, nN, nwg, G, c;
    __host__ __device__ void init(int M, int N, int G_, int c_) { nM = M / BM; nN = N / BM; nwg = nM * nN; G = G_; c = c_; }
    __host__ __device__ bool next(int i, Unit& u) const {
        const long L = (long)i * G + c; if (L >= nwg) return false;
        int wgid = (int)L; { const int q = nwg / NXCD, r = nwg % NXCD, xcd = wgid % NXCD, off = wgid / NXCD; wgid = (xcd < r ? xcd * (q + 1) : r * (q + 1) + (xcd - r) * q) + off; }
        const int nig = WGM * nN, gid = wgid / nig, fm = gid * WGM, gsz = (nM - fm) < WGM ? (nM - fm) : WGM;
        u.pm = fm + ((wgid % nig) % gsz); u.pn = (wgid % nig) / gsz; return true;
    }
    __device__ __forceinline__ void a_ready(const Unit&) const {}
    __device__ __forceinline__ void done(const Unit&) const {}
};

__device__ __forceinline__ unsigned cvt_pk_bf16(float lo, float hi) { unsigned r; asm volatile("v_cvt_pk_bf16_f32 %0, %1, %2" : "=v"(r) : "v"(lo), "v"(hi)); return r; }
typedef float f32x2 __attribute__((ext_vector_type(2)));
typedef float f32x2 __attribute__((ext_vector_type(2)));
template <class Epi, class Sched, bool ALIGN_EPI = false, bool SP2 = false>
__device__ __forceinline__ void gemm_phase(PG8_LAS unsigned char* lds, const Gemm g, const Sched& S, const Epi& E, const int wave_id) {
    int tid_; asm volatile("v_mbcnt_lo_u32_b32 %0, -1, 0\n\tv_mbcnt_hi_u32_b32 %0, -1, %0" : "=v"(tid_)); tid_ += wave_id * 64;
    const int tid = tid_, wid = __builtin_amdgcn_readfirstlane(tid >> 6), lane = tid & 63, wr = wid >> 2, wc = wid & 3, fr = lane & 15, fq = lane >> 4;
    const int K = g.K, nt = K / BK;
    unsigned voffA[2], voffB[2];
#pragma unroll
    for (int i = 0; i < 2; ++i) { int R, C; stage_rc(tid * 16 + i * 8192, R, C); const int Rb = Epi::PERM ? ((R & ~31) + perm32(R & 31)) : R;
        voffA[i] = (unsigned)(R * K + C) * 2u; voffB[i] = (unsigned)(Rb * K + C) * 2u; }
    const size_t kstep = (size_t)(BK * 2);
    const size_t hstep = (size_t)HALF * K * 2;
    const size_t tstep = 2 * hstep;
    const unsigned ldsw = (unsigned)wid * 1024u;
    const int aoff = lds_byte(wr * 64 + fr, fq * 8), boff = lds_byte(wc * 32 + fr, fq * 8);
#define PG8_SA(b, h) (((b) * 2 + (h)) * HTB)
#define PG8_SB(b, h) ((4 + (b) * 2 + (h)) * HTB)
#define PG8_STAGE(bufoff, gbase, voff) do { _Pragma("unroll") for (int _i = 0; _i < 2; ++_i) \
        __builtin_amdgcn_global_load_lds((const unsigned*)((const char*)(gbase) + (voff)[_i]), (PG8_LAS unsigned*)(lds + (bufoff) + ldsw + _i * 8192), 16, 0, 0); } while (0)
#define PG8_LDA(dst, b, h) do { _Pragma("unroll") for (int m = 0; m < 4; ++m) _Pragma("unroll") for (int k = 0; k < 2; ++k) dst[m][k] = *(const PG8_LAS bf16x8*)(lds + PG8_SA(b, h) + aoff + m * 2048 + k * 1024); } while (0)
#define PG8_LDB(dst, b, h) do { _Pragma("unroll") for (int n = 0; n < 2; ++n) _Pragma("unroll") for (int k = 0; k < 2; ++k) dst[n][k] = *(const PG8_LAS bf16x8*)(lds + PG8_SB(b, h) + boff + n * 2048 + k * 1024); } while (0)
#define PG8_MMA(ai, bj, At, Bt) do { __builtin_amdgcn_s_setprio(1); _Pragma("unroll") for (int m = 0; m < 4; ++m) _Pragma("unroll") for (int n = 0; n < 2; ++n) _Pragma("unroll") for (int k = 0; k < 2; ++k) \
        acc[ai][bj][m][n] = __builtin_amdgcn_mfma_f32_16x16x32_bf16(Bt[n][k], At[m][k], acc[ai][bj][m][n], 0, 0, 0); __builtin_amdgcn_s_setprio(0); } while (0)
#define PG8_WAIT_V(n) asm volatile("s_waitcnt vmcnt(" #n ")" ::: "memory")
#define PG8_WAIT_L(n) asm volatile("s_waitcnt lgkmcnt(" #n ")" ::: "memory")
#define PG8_BAR __builtin_amdgcn_s_barrier()
#define PG8_SCHED __builtin_amdgcn_sched_barrier(0)
    Unit cur, nxt; int ui = 0;
    if (!S.next(0, cur)) return;
    f32x4 acc[2][2][4][2];
#pragma unroll
    for (int a = 0; a < 2; ++a)
#pragma unroll
        for (int b = 0; b < 2; ++b)
#pragma unroll
            for (int m = 0; m < 4; ++m)
#pragma unroll
                for (int n = 0; n < 2; ++n) acc[a][b][m][n] = (f32x4){0.f, 0.f, 0.f, 0.f};
    bf16x8 At[4][2], B0[2][2], B1[2][2];
    const char* cA = (const char*)g.A + (size_t)cur.pm * tstep; const char* cB = (const char*)g.Bt + (size_t)cur.pn * tstep;
    S.a_ready(cur);
    if constexpr (SP2) {
        PG8_STAGE(PG8_SB(0, 0), cB, voffB); PG8_STAGE(PG8_SB(0, 1), cB + hstep, voffB); PG8_STAGE(PG8_SA(0, 0), cA, voffA); PG8_STAGE(PG8_SA(0, 1), cA + hstep, voffA);
        if (wr == 1) PG8_BAR;
        PG8_WAIT_V(2); PG8_BAR;
        PG8_STAGE(PG8_SB(1, 0), cB + kstep, voffB); PG8_STAGE(PG8_SA(1, 0), cA + kstep, voffA); PG8_STAGE(PG8_SB(1, 1), cB + hstep + kstep, voffB);
        PG8_WAIT_V(6); PG8_BAR;
    } else {
        PG8_STAGE(PG8_SB(0, 0), cB, voffB); PG8_STAGE(PG8_SA(0, 0), cA, voffA); PG8_STAGE(PG8_SB(0, 1), cB + hstep, voffB); PG8_STAGE(PG8_SA(0, 1), cA + hstep, voffA);
        if (wr == 1) PG8_BAR;
        PG8_WAIT_V(4); PG8_BAR;
        PG8_STAGE(PG8_SB(1, 0), cB + kstep, voffB); PG8_STAGE(PG8_SA(1, 0), cA + kstep, voffA); PG8_STAGE(PG8_SB(1, 1), cB + hstep + kstep, voffB);
        PG8_WAIT_V(6); PG8_BAR;
    }
    for (;;) {
        const bool has_next = S.next(ui + 1, nxt);
        const char* nA = has_next ? (const char*)g.A + (size_t)nxt.pm * tstep : cA; const char* nB = has_next ? (const char*)g.Bt + (size_t)nxt.pn * tstep : cB;
        for (int t = 0; t < nt; t += 2) {
            const bool last = (t == nt - 2);
            const char* a1 = cA + (size_t)(t + 1) * kstep;
            const char* a2 = last ? nA : cA + (size_t)(t + 2) * kstep; const char* b2 = last ? nB : cB + (size_t)(t + 2) * kstep;
            const char* a3 = a2 + kstep; const char* b3 = b2 + kstep;
            if (last && has_next) S.a_ready(nxt);
            if constexpr (SP2) {
            PG8_LDB(B0, 0, 0); PG8_LDB(B1, 0, 1); PG8_SCHED; PG8_LDA(At, 0, 0); PG8_STAGE(PG8_SA(1, 1), a1 + hstep, voffA);
            PG8_WAIT_V(8); PG8_WAIT_L(0); PG8_BAR; PG8_MMA(0, 0, At, B0); PG8_MMA(0, 1, At, B1); PG8_BAR; PG8_SCHED;
            PG8_LDA(At, 0, 1); PG8_STAGE(PG8_SB(0, 0), b2, voffB); PG8_STAGE(PG8_SB(0, 1), b2 + hstep, voffB); PG8_STAGE(PG8_SA(0, 0), a2, voffA);
            PG8_WAIT_V(8); PG8_WAIT_L(0); PG8_BAR; PG8_MMA(1, 0, At, B0); PG8_MMA(1, 1, At, B1); PG8_BAR; PG8_SCHED;
            PG8_LDB(B0, 1, 0); PG8_LDB(B1, 1, 1); PG8_SCHED; PG8_LDA(At, 1, 0); PG8_STAGE(PG8_SA(0, 1), a2 + hstep, voffA);
            PG8_WAIT_V(8); PG8_WAIT_L(0); PG8_BAR; PG8_MMA(0, 0, At, B0); PG8_MMA(0, 1, At, B1); PG8_BAR; PG8_SCHED;
            PG8_LDA(At, 1, 1); PG8_STAGE(PG8_SB(1, 0), b3, voffB); PG8_STAGE(PG8_SB(1, 1), b3 + hstep, voffB); PG8_STAGE(PG8_SA(1, 0), a3, voffA);
            PG8_WAIT_V(8); PG8_WAIT_L(0); PG8_BAR; PG8_MMA(1, 0, At, B0); PG8_MMA(1, 1, At, B1); PG8_BAR; PG8_SCHED;
            } else {
            PG8_LDB(B0, 0, 0); PG8_SCHED; PG8_LDA(At, 0, 0); PG8_STAGE(PG8_SA(1, 1), a1 + hstep, voffA);
            PG8_WAIT_L(8); PG8_BAR; PG8_WAIT_L(0); PG8_MMA(0, 0, At, B0); PG8_BAR; PG8_SCHED;
            PG8_LDB(B1, 0, 1); PG8_STAGE(PG8_SB(0, 0), b2, voffB);
            PG8_BAR; PG8_WAIT_L(0); PG8_MMA(0, 1, At, B1); PG8_BAR;
            PG8_LDA(At, 0, 1); PG8_STAGE(PG8_SA(0, 0), a2, voffA);
            PG8_BAR; PG8_WAIT_L(0); PG8_MMA(1, 0, At, B0); PG8_BAR; PG8_SCHED;
            PG8_STAGE(PG8_SB(0, 1), b2 + hstep, voffB);
            PG8_WAIT_V(6); PG8_BAR; PG8_MMA(1, 1, At, B1); PG8_BAR;
            PG8_LDB(B0, 1, 0); PG8_SCHED; PG8_LDA(At, 1, 0); PG8_STAGE(PG8_SA(0, 1), a2 + hstep, voffA);
            PG8_WAIT_L(8); PG8_BAR; PG8_WAIT_L(0); PG8_MMA(0, 0, At, B0); PG8_BAR; PG8_SCHED;
            PG8_LDB(B1, 1, 1); PG8_STAGE(PG8_SB(1, 0), b3, voffB);
            PG8_BAR; PG8_WAIT_L(0); PG8_MMA(0, 1, At, B1); PG8_BAR;
            PG8_LDA(At, 1, 1); PG8_STAGE(PG8_SA(1, 0), a3, voffA);
            PG8_BAR; PG8_WAIT_L(0); PG8_MMA(1, 0, At, B0); PG8_BAR; PG8_SCHED;
            PG8_STAGE(PG8_SB(1, 1), b3 + hstep, voffB);
            PG8_WAIT_V(6); PG8_BAR; PG8_MMA(1, 1, At, B1); PG8_BAR;
            }
        }
        if constexpr (ALIGN_EPI) { if (wr == 0) PG8_BAR; }
        if constexpr (!Epi::AFTER_DRAIN) { E(acc, cur, wr, wc, fr, fq); S.done(cur); }
        if (!has_next) break;
#pragma unroll
        for (int a = 0; a < 2; ++a)
#pragma unroll
            for (int b = 0; b < 2; ++b)
#pragma unroll
                for (int m = 0; m < 4; ++m)
#pragma unroll
                    for (int n = 0; n < 2; ++n) acc[a][b][m][n] = (f32x4){0.f, 0.f, 0.f, 0.f};
        cur = nxt; cA = nA; cB = nB; ++ui;
        if constexpr (ALIGN_EPI) { if (wr == 1) PG8_BAR; }
    }
    PG8_WAIT_V(0);
    if constexpr (!ALIGN_EPI) { if (wr == 0) PG8_BAR; }
    PG8_BAR;
    if constexpr (Epi::AFTER_DRAIN) { E.fused(acc, cur, wr, wc, fr, fq, lds, wid, lane); S.done(cur); }
#undef PG8_SA
#undef PG8_SB
#undef PG8_STAGE
#undef PG8_LDA
#undef PG8_LDB
#undef PG8_MMA
#undef PG8_WAIT_V
#undef PG8_WAIT_L
#undef PG8_BAR
#undef PG8_SCHED
}
}

constexpr int NWAVES = 8;
constexpr int DM = 2048, SEQ = 16384, NBATCH = 2, NTOK = NBATCH * SEQ;
constexpr int DCA = 1024, DINP = 5120, NEXP = 64, DEXP = 1024, LISTCAP = 32768, NMODC = 6 * DM;
constexpr int PW = 3072;
constexpr float EPS = 1e-6f;

constexpr size_t MiB = 1u << 20;
constexpr size_t WS_CTL = 0, CTL_ZERO_BYTES = 65536;
constexpr size_t WS_MOD = 1 * MiB;
constexpr size_t WS_WIN = 2 * MiB;
constexpr size_t WS_WOUT = 22 * MiB;
constexpr size_t WS_LISTA = 30 * MiB;
constexpr size_t WS_LISTW = 38 * MiB;
constexpr size_t WS_WR = 46 * MiB;
constexpr size_t WS_WGU = 64 * MiB;
constexpr size_t WS_WD = 576 * MiB;
constexpr size_t WS_H = 832 * MiB;
constexpr size_t WS_P = 960 * MiB;
constexpr size_t WS_Y = 1152 * MiB;
constexpr size_t WS_O = 1280 * MiB;
constexpr size_t WS_X1 = 1410 * MiB;
constexpr size_t WS_END = 1538 * MiB;
constexpr int CW_TMO = 0, CW_Q = 64, CW_DONE = 128, CW_BAR = 4096, CW_CNT = 8192;

constexpr int RING_OFF = 0, RING_BYTES = 131072;
constexpr int LDSCTL_OFF = 143360;
constexpr int TAB_OFF = LDSCTL_OFF + 1024;
constexpr int LDS_BYTES = 147456;

#define GAS __attribute__((address_space(1)))
#define LAS __attribute__((address_space(3)))
typedef unsigned short bf16;
typedef unsigned v4u __attribute__((ext_vector_type(4)));
typedef unsigned v2u __attribute__((ext_vector_type(2)));
using pg8::f32x4; using pg8::f32x2; using pg8::bf16x8;
typedef GAS unsigned gu32;
#define RLX_AGENT __ATOMIC_RELAXED, __HIP_MEMORY_SCOPE_AGENT
#define LDS_WAIT() asm volatile("s_waitcnt lgkmcnt(0)" ::: "memory")
__device__ __forceinline__ unsigned f2bf(float f) { unsigned u = __builtin_bit_cast(unsigned, f); return (u + 0x7fffu + ((u >> 16) & 1u)) >> 16; }
__device__ __forceinline__ unsigned pk2(float lo, float hi) { return f2bf(lo) | (f2bf(hi) << 16); }
__device__ __forceinline__ float bf_lo(unsigned u) { return __builtin_bit_cast(float, u << 16); }
__device__ __forceinline__ float bf_hi(unsigned u) { return __builtin_bit_cast(float, u & 0xffff0000u); }
__device__ __forceinline__ float wave_sum(float v) {
#pragma unroll
    for (int o = 1; o < 64; o <<= 1) v += __shfl_xor(v, o);
    return v;
}
constexpr float SC_H = 16.0f, SC_WGU = 64.0f, SC_HID = 8.0f, SC_WD = 32.0f;
__device__ __forceinline__ unsigned pk4_fp8(float a, float b, float c, float d) {
    a = __builtin_fminf(__builtin_fmaxf(a, -448.0f), 448.0f); b = __builtin_fminf(__builtin_fmaxf(b, -448.0f), 448.0f);
    c = __builtin_fminf(__builtin_fmaxf(c, -448.0f), 448.0f); d = __builtin_fminf(__builtin_fmaxf(d, -448.0f), 448.0f);
    int w = __builtin_amdgcn_cvt_pk_fp8_f32(a, b, 0, false); w = __builtin_amdgcn_cvt_pk_fp8_f32(c, d, w, true); return (unsigned)w; }
#define DPP_STEP(v, ctrl) ((v) + __builtin_bit_cast(float, __builtin_amdgcn_update_dpp(0, __builtin_bit_cast(int, (v)), (ctrl), 0xF, 0xF, true)))
__device__ __forceinline__ float wave_sum_dpp(float v) {
    v = DPP_STEP(v, 0xB1);
    v = DPP_STEP(v, 0x4E);
    v = DPP_STEP(v, 0x141);
    v = DPP_STEP(v, 0x140);
    const int iv = __builtin_bit_cast(int, v);
    const float r0 = __builtin_bit_cast(float, __builtin_amdgcn_readlane(iv, 0)), r1 = __builtin_bit_cast(float, __builtin_amdgcn_readlane(iv, 16));
    const float r2 = __builtin_bit_cast(float, __builtin_amdgcn_readlane(iv, 32)), r3 = __builtin_bit_cast(float, __builtin_amdgcn_readlane(iv, 48));
    return (r0 + r1) + (r2 + r3);
}
__device__ __forceinline__ void wave_sum3_dpp(float& a, float& b, float& c) {
    a = DPP_STEP(a, 0xB1); b = DPP_STEP(b, 0xB1); c = DPP_STEP(c, 0xB1);
    a = DPP_STEP(a, 0x4E); b = DPP_STEP(b, 0x4E); c = DPP_STEP(c, 0x4E);
    a = DPP_STEP(a, 0x141); b = DPP_STEP(b, 0x141); c = DPP_STEP(c, 0x141);
    a = DPP_STEP(a, 0x140); b = DPP_STEP(b, 0x140); c = DPP_STEP(c, 0x140);
    const int ia = __builtin_bit_cast(int, a), ib = __builtin_bit_cast(int, b), ic = __builtin_bit_cast(int, c);
#define RL_(v, l) __builtin_bit_cast(float, __builtin_amdgcn_readlane((v), (l)))
    a = (RL_(ia, 0) + RL_(ia, 16)) + (RL_(ia, 32) + RL_(ia, 48));
    b = (RL_(ib, 0) + RL_(ib, 16)) + (RL_(ib, 32) + RL_(ib, 48));
    c = (RL_(ic, 0) + RL_(ic, 16)) + (RL_(ic, 32) + RL_(ic, 48));
#undef RL_
}
typedef _Float16 f16x2_ __attribute__((ext_vector_type(2)));
typedef _Float16 f16x8_ __attribute__((ext_vector_type(8)));
__device__ __forceinline__ unsigned pkh2(float lo, float hi) { const f16x2_ h = {(_Float16)lo, (_Float16)hi}; return __builtin_bit_cast(unsigned, h); }
__device__ __forceinline__ float h_lo(unsigned u) { return (float)__builtin_bit_cast(f16x2_, u).x; }
__device__ __forceinline__ float h_hi(unsigned u) { return (float)__builtin_bit_cast(f16x2_, u).y; }
__device__ __forceinline__ unsigned cvt2bf(float lo, float hi) { unsigned r; asm volatile("v_cvt_pk_bf16_f32 %0, %1, %2" : "=v"(r) : "v"(lo), "v"(hi)); return r; }
__device__ __forceinline__ float dot4(f32x4 a, f32x4 b) { return (a.x * b.x + a.y * b.y) + (a.z * b.z + a.w * b.w); }

__device__ __forceinline__ int lane_id_fresh() { int l; asm volatile("v_mbcnt_lo_u32_b32 %0, -1, 0\n\tv_mbcnt_hi_u32_b32 %0, -1, %0" : "=v"(l)); return l; }
#define XB_TMO      128
#define XB_XCNT(j)  (256  + 64 * (j))
#define XB_XSUB(j)  (1280 + 64 * (j))
#define XB_XGEN(j)  (2304 + 64 * (j))
#define XB_TOP      3328
#define XB_TOPGEN   3392
#define XCD_BAR_WORDS 3456
#define XB_SPIN_CAP (1u << 22)

__device__ __forceinline__ unsigned xb_ld(unsigned* p)              { return __hip_atomic_load(p, __ATOMIC_RELAXED, __HIP_MEMORY_SCOPE_AGENT); }
__device__ __forceinline__ unsigned xb_add(unsigned* p, unsigned v) { return __hip_atomic_fetch_add(p, v, __ATOMIC_RELAXED, __HIP_MEMORY_SCOPE_AGENT); }
__device__ __forceinline__ unsigned xb_xcc_id() { return (unsigned)__builtin_amdgcn_s_getreg((3 << 11) | 20) & 0xFu; }
#define XB_SPIN(cond, bar) do { unsigned _sp = 0; while (cond) { __builtin_amdgcn_s_sleep(1); \
    if ((++_sp & 255u) == 0u) { if (xb_ld(&(bar)[XB_TMO])) break; if (_sp > XB_SPIN_CAP) { atomicAdd(&(bar)[XB_TMO], 1u); break; } } } } while (0)

struct XcdBarrier { unsigned* bar; unsigned x; volatile LAS unsigned* st; };

__device__ __forceinline__ XcdBarrier xcd_barrier_post(unsigned* bar, volatile LAS unsigned* st) {
    XcdBarrier b; b.bar = bar; b.x = xb_xcc_id(); b.st = st;
    if (threadIdx.x == 0) (void)xb_add(&bar[XB_XCNT(b.x)], 1u);
    return b;
}
__device__ __forceinline__ void xcd_barrier_complete(unsigned* bar, unsigned x, unsigned& nloc, unsigned& nx) {
    const unsigned G = gridDim.x * gridDim.y * gridDim.z;
    unsigned sum, cnt, mine, sp = 0u;
    for (;;) {
        sum = 0u; cnt = 0u; mine = 0u;
#pragma unroll
        for (unsigned j = 0; j < 16; ++j) { const unsigned c = xb_ld(&bar[XB_XCNT(j)]); sum += c; cnt += (c > 0u) ? 1u : 0u; mine = (j == x) ? c : mine; }
        if (sum == G) break;
        __builtin_amdgcn_s_sleep(1);
        if ((++sp & 255u) == 0u) { if (xb_ld(&bar[XB_TMO])) break; if (sp > XB_SPIN_CAP) { atomicAdd(&bar[XB_TMO], 1u); break; } }
    }
    nloc = mine > 0u ? mine : 1u; nx = cnt > 0u ? cnt : 1u;
}
__device__ __forceinline__ void xcd_barrier(const XcdBarrier& b, const int wave_id) {
    asm volatile("s_waitcnt vmcnt(0)" ::: "memory");
    __syncthreads();
    if (wave_id == 0 && lane_id_fresh() == 0) {
        unsigned* bar = b.bar; asm volatile("" : "+s"(bar));
        __builtin_amdgcn_s_waitcnt(0);
        unsigned nloc = b.st[0], nx = b.st[1];
        if (nloc == 0u) { xcd_barrier_complete(bar, b.x, nloc, nx); b.st[0] = nloc; b.st[1] = nx; }
        const unsigned old = xb_add(&bar[XB_XSUB(b.x)], 1u);
        const unsigned gen = old / nloc;
        if (old + 1u == (gen + 1u) * nloc) {
            __builtin_amdgcn_fence(__ATOMIC_RELEASE, "agent");
            asm volatile("s_waitcnt vmcnt(0)" ::: "memory");
            const unsigned og = xb_add(&bar[XB_TOP], 1u);
            const unsigned tg = og / nx;
            if (og + 1u == (tg + 1u) * nx) xb_add(&bar[XB_TOPGEN], 1u);
            else XB_SPIN(xb_ld(&bar[XB_TOPGEN]) == tg, bar);
            __builtin_amdgcn_fence(__ATOMIC_ACQUIRE, "agent");
            xb_add(&bar[XB_XGEN(b.x)], 1u);
            asm volatile("s_waitcnt vmcnt(0)" ::: "memory");
        } else {
            XB_SPIN(xb_ld(&bar[XB_XGEN(b.x)]) == gen, bar);
            __builtin_amdgcn_fence(__ATOMIC_ACQUIRE, "agent");
            asm volatile("s_waitcnt vmcnt(0)" ::: "memory");
        }
    }
    __syncthreads();
}

struct Args {
    const float* in[23]; float* out_; unsigned char* ws;
#define ARGS_IN(name, k) __device__ __forceinline__ const float* name() const { return in[k]; }
    ARGS_IN(x, 0) ARGS_IN(c, 1) ARGS_IN(w_ada, 2) ARGS_IN(b_ada, 3) ARGS_IN(g_pre1, 4) ARGS_IN(g_post1, 5) ARGS_IN(w_in, 6) ARGS_IN(conv_a, 7) ARGS_IN(norm_a, 8)
    ARGS_IN(conv_b, 9) ARGS_IN(conv_b_bias, 10) ARGS_IN(ln_g, 11) ARGS_IN(ln_b, 12) ARGS_IN(w_out, 13) ARGS_IN(g_pre2, 14) ARGS_IN(g_post2, 15) ARGS_IN(w_rg, 16)
    ARGS_IN(b_rg, 17) ARGS_IN(w_re, 18) ARGS_IN(b_re, 19) ARGS_IN(w_eg, 20) ARGS_IN(w_eu, 21) ARGS_IN(w_ed, 22)
#undef ARGS_IN
    __device__ __forceinline__ float* out() const { return out_; }
    __device__ __forceinline__ unsigned* ctl() const { return (unsigned*)(ws + WS_CTL); }
    __device__ __forceinline__ float* mod() const { return (float*)(ws + WS_MOD); }
    __device__ __forceinline__ bf16* WIN() const { return (bf16*)(ws + WS_WIN); }
    __device__ __forceinline__ bf16* WOUT() const { return (bf16*)(ws + WS_WOUT); }
    __device__ __forceinline__ unsigned char* WGU() const { return ws + WS_WGU; }
    __device__ __forceinline__ unsigned char* WD() const { return ws + WS_WD; }
    __device__ __forceinline__ bf16* H() const { return (bf16*)(ws + WS_H); }
    __device__ __forceinline__ bf16* P() const { return (bf16*)(ws + WS_P); }
    __device__ __forceinline__ bf16* Y() const { return (bf16*)(ws + WS_Y); }
    __device__ __forceinline__ bf16* O() const { return (bf16*)(ws + WS_O); }
    __device__ __forceinline__ unsigned char* HID() const { return ws + WS_P; }
    __device__ __forceinline__ unsigned char* H8() const { return ws + WS_H; }
    __device__ __forceinline__ bf16* YD() const { return (bf16*)(ws + WS_Y); }
    __device__ __forceinline__ int* lista() const { return (int*)(ws + WS_LISTA); }
    __device__ __forceinline__ float* listw() const { return (float*)(ws + WS_LISTW); }
    __device__ __forceinline__ bf16* WR() const { return (bf16*)(ws + WS_WR); }
    __device__ __forceinline__ bf16* X1() const { return (bf16*)(ws + WS_X1); }
};
struct Frame { LAS unsigned char* lds; int tid, lane, wave, vcu, G; };
__device__ __forceinline__ Frame phase_frame(const Frame& F0) { Frame F = F0; const int l = lane_id_fresh(); F.lane = l; F.tid = F0.wave * 64 + l; return F; }

__device__ __forceinline__ void p0_ada(const Frame& F, const Args& A) {
    if ((int)blockIdx.x >= 192) return;
    LAS float* sc = (LAS float*)(F.lds + RING_OFF);
    LAS float* red = (LAS float*)(F.lds + RING_OFF + 16384);
    for (int i = F.tid; i < 2 * DM; i += NWAVES * 64) { const int b = i >> 11, k = i & (DM - 1); const float cv = A.c()[b * DM + k]; sc[k * 2 + b] = cv / (1.0f + expf(-cv)); }
    __syncthreads();
    for (int it = blockIdx.x; it < 192; it += F.G) {
        const int k0 = F.wave * 256;
        const float* wp = A.w_ada() + (size_t)k0 * NMODC + it * 64 + F.lane;
        float a0 = 0.f, a1 = 0.f;
        for (int kk = 0; kk < 256; kk += 64) {
            float wv[64];
#pragma unroll
            for (int k = 0; k < 64; ++k) wv[k] = wp[(size_t)(kk + k) * NMODC];
#pragma unroll
            for (int k = 0; k < 64; ++k) { const f32x2 s = *(const LAS f32x2*)(sc + (k0 + kk + k) * 2); a0 += s.x * wv[k]; a1 += s.y * wv[k]; }
        }
        red[(F.wave * 2 + 0) * 64 + F.lane] = a0; red[(F.wave * 2 + 1) * 64 + F.lane] = a1;
        __syncthreads();
        if (F.tid < 128) { const int b = F.tid >> 6, l = F.tid & 63; float s = 0.f;
#pragma unroll
            for (int w = 0; w < 8; ++w) s += red[(w * 2 + b) * 64 + l];
            A.mod()[b * NMODC + it * 64 + l] = s + A.b_ada()[it * 64 + l]; }
        __syncthreads();
    }
}
__host__ __device__ __forceinline__ int inproj_row(int n0) {
    if (n0 < 1024) return n0;
    const int seg = (n0 - 1024) >> 10, off = (n0 - 1024) & 1023, j = off >> 7, r = off & 127;
    return (seg < 2 ? 1024 : 3072) + 256 * j + 128 * (seg & 1) + r;
}
__device__ __forceinline__ void transpose_item_bf16(const float* W, int N, int k0, int n0, bf16* dst, int ldk, LAS float* scr, int lane) {
    float tv[32];
    { const float* wp = W + (size_t)(k0 + (lane >> 5)) * N + n0 + (lane & 31);
#pragma unroll
      for (int i = 0; i < 32; ++i) tv[i] = wp[(size_t)(2 * i) * N]; }
#pragma unroll
    for (int i = 0; i < 32; ++i) scr[(2 * i + (lane >> 5)) * 33 + (lane & 31)] = tv[i];
    LDS_WAIT(); asm volatile("" ::: "memory");
    const int c = lane & 7;
#pragma unroll
    for (int j = 0; j < 4; ++j) { const int n = (lane >> 3) + 8 * j; const LAS float* sp = scr + (8 * c) * 33 + n;
        v4u o; o.x = pk2(sp[0 * 33], sp[1 * 33]); o.y = pk2(sp[2 * 33], sp[3 * 33]); o.z = pk2(sp[4 * 33], sp[5 * 33]); o.w = pk2(sp[6 * 33], sp[7 * 33]);
        *(v4u*)(dst + (size_t)n * ldk + 8 * c) = o; }
    LDS_WAIT(); asm volatile("" ::: "memory");
}
__device__ __forceinline__ void p0_router_weights(const Frame& F, const Args& A) {
    const int gt = F.vcu * NWAVES * 64 + F.tid, NGT = F.G * NWAVES * 64;
    for (int it = gt; it < 8 * 8 * 5 * 64; it += NGT) {
        const int l = it & 63, nf = (it >> 6) % 5, wc = it / 320, c = wc & 7, w = wc >> 3;
        const int n = 16 * nf + (l & 15), kg = l >> 4;
        float v[8];
#pragma unroll
        for (int j = 0; j < 8; ++j) { const int k = 256 * w + 64 * (c >> 1) + 16 * kg + 8 * (c & 1) + j;
            v[j] = n < 8 ? A.w_rg()[k * 8 + n] : (n < 72 ? A.w_re()[((size_t)((n - 8) >> 3) * DM + k) * 8 + ((n - 8) & 7)] : 0.f); }
        v4u* dst = (v4u*)A.WR() + (size_t)((w * 8 + c) * 5 + nf) * 64 + l;
        dst[0] = (v4u){pkh2(v[0], v[1]), pkh2(v[2], v[3]), pkh2(v[4], v[5]), pkh2(v[6], v[7])};
    }
}
constexpr int P0X_ITEMS = 3 * NEXP * 64;
struct XItem { const float* src; unsigned char* dst; int N; float scale; };
__device__ __forceinline__ XItem p0x_item(const Args& A, int it, int w) {
    XItem t; const int mat = it / (NEXP * 64), r = it - mat * (NEXP * 64), e = r >> 6, rr = r & 63;
    if (mat < 2) { const int kt = rr >> 2, nb = rr & 3; t.N = DEXP; t.scale = SC_WGU;
        t.src = (mat ? A.w_eu() : A.w_eg()) + (size_t)e * DM * DEXP + (size_t)(128 * kt) * DEXP + 256 * nb;
        const int nn = 32 * w, drow = 256 * (2 * nb + (nn >> 7)) + 128 * mat + (nn & 127);
        t.dst = A.WGU() + ((size_t)(e * 16 + kt) * 2048 + drow) * 128; }
    else { const int kt = rr >> 3, nb = rr & 7; t.N = DM; t.scale = SC_WD;
        t.src = A.w_ed() + (size_t)e * DEXP * DM + (size_t)(128 * kt) * DM + 256 * nb;
        t.dst = A.WD() + ((size_t)(e * 8 + kt) * 2048 + 256 * nb + 32 * w) * 128; }
    return t;
}
__device__ __forceinline__ void p0x_load(const XItem& t, int w, int lane, f32x4 (&v)[16]) {
    const f32x4* p = (const f32x4*)(t.src + (size_t)(16 * w) * t.N) + lane;
#pragma unroll
    for (int j = 0; j < 16; ++j) v[j] = *(const f32x4*)((const float*)p + (size_t)j * t.N);
}
#define XW_BAR() do { LDS_WAIT(); __builtin_amdgcn_s_barrier(); asm volatile("" ::: "memory"); } while (0)
__device__ __forceinline__ void xw_put(LAS float* tile, int w, int lane, const f32x4 (&v)[16]) {
#pragma unroll
    for (int j = 0; j < 16; ++j) *(LAS f32x4*)(tile + (16 * w + j) * 260 + 4 * lane) = v[j];
}
__device__ __forceinline__ void xw_emit(const LAS float* tile, const XItem& cur, int w, int lane) {
    const int n = lane & 31, kh = lane >> 5; const float sc = cur.scale;
    const LAS float* col = tile + 32 * w + n;
#pragma unroll
    for (int q = 0; q < 4; ++q) { const LAS float* sp = col + (32 * q + 16 * kh) * 260;
        v4u o;
        o.x = pk4_fp8(sp[0 * 260] * sc, sp[1 * 260] * sc, sp[2 * 260] * sc, sp[3 * 260] * sc);     o.y = pk4_fp8(sp[4 * 260] * sc, sp[5 * 260] * sc, sp[6 * 260] * sc, sp[7 * 260] * sc);
        o.z = pk4_fp8(sp[8 * 260] * sc, sp[9 * 260] * sc, sp[10 * 260] * sc, sp[11 * 260] * sc);   o.w = pk4_fp8(sp[12 * 260] * sc, sp[13 * 260] * sc, sp[14 * 260] * sc, sp[15 * 260] * sc);
        *(v4u*)(cur.dst + (size_t)n * 128 + 32 * q + 16 * kh) = o; }
}
template <class T> __device__ __forceinline__ T* uniform_ptr(T* p) {
    const unsigned long long v = (unsigned long long)p; const unsigned lo = (unsigned)__builtin_amdgcn_readfirstlane((int)(unsigned)v), hi = (unsigned)__builtin_amdgcn_readfirstlane((int)(unsigned)(v >> 32));
    return (T*)(((unsigned long long)hi << 32) | lo);
}
__device__ __forceinline__ void xq_issue(const unsigned* ctl, unsigned& cl, unsigned& sv) {
    asm volatile("s_nop 4\n\tglobal_atomic_add %0, %2, %3, %4 offset:256 sc0\n\tglobal_load_dword %1, %2, %4 offset:512 sc1" : "=&v"(cl), "=&v"(sv) : "v"(0u), "v"(1u), "s"(ctl) : "memory");
}
static_assert(CW_Q * 4 == 256 && CW_DONE * 4 == 512, "xq_issue hard-codes the byte offsets of the queue and stop words");
__device__ __forceinline__ void expert_worker(const Frame& F, const Args& A, const unsigned stop_target) {
    LAS float* tile = (LAS float*)(F.lds + RING_OFF);
    volatile LAS int* qs = (volatile LAS int*)(F.lds + LDSCTL_OFF + 64);
    const int w = F.wave, lane = F.lane;
    const unsigned* ctl = uniform_ptr(A.ctl());
    if (F.tid == 0) {
        const bool stop = stop_target != 0u && __hip_atomic_load(ctl + CW_DONE, RLX_AGENT) >= stop_target;
        const int base = stop ? P0X_ITEMS : (int)__hip_atomic_fetch_add(A.ctl() + CW_Q, 4u, RLX_AGENT);
        qs[0] = base; qs[1] = base + 1; qs[2] = base + 2; qs[3] = base + 3; }
    __syncthreads();
    int i0 = qs[0], i1 = qs[1], i2 = qs[2], i3 = qs[3];
    if (i0 >= P0X_ITEMS) return;
    unsigned cl = 0u, sv = 0u; bool pend = (F.wave == 0) && i3 < P0X_ITEMS, stopped = false;
    if (pend && lane == 0) xq_issue(ctl, cl, sv);
    XItem c0 = p0x_item(A, i0, w), c1 = p0x_item(A, i1 < P0X_ITEMS ? i1 : i0, w); f32x4 va[16], vb[16];
    p0x_load(c0, w, lane, va); p0x_load(c1, w, lane, vb);
#define XW_CLAIM(slot) do { if (F.wave == 0) { int _n = P0X_ITEMS; \
        if (pend) { asm volatile("s_waitcnt vmcnt(16)" ::: "memory"); asm volatile("" : "+v"(cl), "+v"(sv)); _n = __builtin_amdgcn_readfirstlane((int)cl); \
            if (stop_target != 0u && (unsigned)__builtin_amdgcn_readfirstlane((int)sv) >= stop_target) stopped = true; } \
        if (lane == 0) qs[slot] = _n; \
        pend = !stopped && _n < P0X_ITEMS; \
        if (pend && lane == 0) xq_issue(ctl, cl, sv); } } while (0)
    for (;;) {
        xw_put(tile, w, lane, va);
        XW_CLAIM(0);
        XW_BAR();
        const XItem c2 = p0x_item(A, i2 < P0X_ITEMS ? i2 : i0, w);
        p0x_load(c2, w, lane, va);
        xw_emit(tile, c0, w, lane);
        XW_BAR();
        if (i1 >= P0X_ITEMS) break;
        const int i4 = qs[0];
        xw_put(tile, w, lane, vb);
        XW_CLAIM(1);
        XW_BAR();
        const XItem c3 = p0x_item(A, i3 < P0X_ITEMS ? i3 : i1, w);
        p0x_load(c3, w, lane, vb);
        xw_emit(tile, c1, w, lane);
        XW_BAR();
        if (i2 >= P0X_ITEMS) break;
        i0 = i2; c0 = c2; i1 = i3; c1 = c3; i2 = i4; i3 = qs[1];
    }
#undef XW_CLAIM
}
__device__ __forceinline__ void p0_weights(const Frame& F, const Args& A) {
    LAS float* scr = (LAS float*)(F.lds + RING_OFF + F.wave * 16896);
    const int gw = F.vcu * NWAVES + F.wave, NGW = F.G * NWAVES;
    constexpr int I_IN = 32 * 160, I_OUT = 32 * 64;
    for (int it = gw; it < I_IN + I_OUT; it += NGW) {
        if (it < I_IN) { const int kb = it / 160, nb = it % 160, n0 = 32 * nb; transpose_item_bf16(A.w_in(), DINP, 64 * kb, n0, A.WIN() + (size_t)inproj_row(n0) * DM + 64 * kb, DM, scr, F.lane); }
        else { const int r = it - I_IN, kb = r / 64, nb = r % 64, n0 = 32 * nb; transpose_item_bf16(A.w_out(), DM, 64 * kb, n0, A.WOUT() + (size_t)n0 * DM + 64 * kb, DM, scr, F.lane); }
    }
}

__device__ __forceinline__ void p1_norm1(const Frame& F, const Args& A) {
    const int gw = F.vcu * NWAVES + F.wave, NGW = F.G * NWAVES;
    f32x4 a1[8], sh[8]; int bcur = -1;
    for (int m0 = gw; m0 < NTOK; m0 += 2 * NGW) {
        const int m1 = m0 + NGW; const bool has1 = (m1 < NTOK) && ((m1 >> 14) == (m0 >> 14));
        const f32x4* xr0 = (const f32x4*)(A.x() + (size_t)m0 * DM) + 2 * F.lane;
        const f32x4* xr1 = (const f32x4*)(A.x() + (size_t)(has1 ? m1 : m0) * DM) + 2 * F.lane;
        f32x4 v0[8], v1[8];
#pragma unroll
        for (int j = 0; j < 4; ++j) { v0[2 * j] = xr0[128 * j]; v0[2 * j + 1] = xr0[128 * j + 1]; v1[2 * j] = xr1[128 * j]; v1[2 * j + 1] = xr1[128 * j + 1]; }
        if ((m0 >> 14) != bcur) { bcur = m0 >> 14;
            const f32x4* g = (const f32x4*)A.g_pre1() + 2 * F.lane; const f32x4* shp = (const f32x4*)(A.mod() + bcur * NMODC) + 2 * F.lane; const f32x4* scp = (const f32x4*)(A.mod() + bcur * NMODC + DM) + 2 * F.lane;
#pragma unroll
            for (int j = 0; j < 4; ++j) { a1[2 * j] = g[128 * j] * (scp[128 * j] + 1.0f); a1[2 * j + 1] = g[128 * j + 1] * (scp[128 * j + 1] + 1.0f); sh[2 * j] = shp[128 * j]; sh[2 * j + 1] = shp[128 * j + 1]; } }
        float s0 = 0.f, s1 = 0.f;
#pragma unroll
        for (int j = 0; j < 8; ++j) { s0 += dot4(v0[j], v0[j]); s1 += dot4(v1[j], v1[j]); }
        const float r0 = 1.0f / sqrtf(wave_sum(s0) * (1.0f / DM) + EPS), r1 = 1.0f / sqrtf(wave_sum(s1) * (1.0f / DM) + EPS);
        { v4u* o16 = (v4u*)(A.H() + (size_t)m0 * DM) + F.lane;
#pragma unroll
          for (int j = 0; j < 4; ++j) { const f32x4 ha = v0[2 * j] * r0 * a1[2 * j] + sh[2 * j], hb = v0[2 * j + 1] * r0 * a1[2 * j + 1] + sh[2 * j + 1];
              o16[64 * j] = (v4u){pg8::cvt_pk_bf16(ha.x, ha.y), pg8::cvt_pk_bf16(ha.z, ha.w), pg8::cvt_pk_bf16(hb.x, hb.y), pg8::cvt_pk_bf16(hb.z, hb.w)}; } }
        if (has1) { v4u* o16 = (v4u*)(A.H() + (size_t)m1 * DM) + F.lane;
#pragma unroll
          for (int j = 0; j < 4; ++j) { const f32x4 ha = v1[2 * j] * r1 * a1[2 * j] + sh[2 * j], hb = v1[2 * j + 1] * r1 * a1[2 * j + 1] + sh[2 * j + 1];
              o16[64 * j] = (v4u){pg8::cvt_pk_bf16(ha.x, ha.y), pg8::cvt_pk_bf16(ha.z, ha.w), pg8::cvt_pk_bf16(hb.x, hb.y), pg8::cvt_pk_bf16(hb.z, hb.w)}; } }
        else if (m1 < NTOK) { m0 -= NGW; }
    }
}

__device__ __forceinline__ float sigmoidf_(float v) { return __builtin_amdgcn_rcpf(1.0f + __expf(-v)); }
constexpr size_t OTILE_PITCH = 65536 + 128;
struct EpiStoreFrag {
    static constexpr bool PERM = true, AFTER_DRAIN = false;
    bf16* O; int ntn;
    __device__ __forceinline__ void operator()(const pg8::f32x4 (&acc)[2][2][4][2], const pg8::Unit& u, int wr, int wc, int fr, int fq) const {
        bf16* base = O + ((size_t)(u.pm * ntn + u.pn) * OTILE_PITCH) + (size_t)((wr * 4 + wc) * 16) * 512 + (fq * 16 + fr) * 8;
#pragma unroll
        for (int ai = 0; ai < 2; ++ai)
#pragma unroll
            for (int m = 0; m < 4; ++m)
#pragma unroll
                for (int bj = 0; bj < 2; ++bj) { const pg8::f32x4 v0 = acc[ai][bj][m][0], v1 = acc[ai][bj][m][1];
                    v4u w; w.x = pg8::cvt_pk_bf16(v0[0], v0[1]); w.y = pg8::cvt_pk_bf16(v0[2], v0[3]); w.z = pg8::cvt_pk_bf16(v1[0], v1[1]); w.w = pg8::cvt_pk_bf16(v1[2], v1[3]);
                    *(v4u*)(base + ((ai * 4 + m) * 2 + bj) * 512) = w; }
    }
};
struct EpiInProj {
    static constexpr bool PERM = true, AFTER_DRAIN = false;
    bf16* P;
    __device__ __forceinline__ void operator()(const pg8::f32x4 (&acc)[2][2][4][2], const pg8::Unit& u, int wr, int wc, int fr, int fq) const {
        unsigned char* pmb = (unsigned char*)P + (size_t)u.pm * 1572864; const int rowt = wr * 64 + fr;
        if (u.pn < 4) {
            unsigned char* tb = pmb + u.pn * 131072 + (wc * 32 + 8 * fq) * 2;
#pragma unroll
            for (int ai = 0; ai < 2; ++ai)
#pragma unroll
                for (int m = 0; m < 4; ++m) { unsigned char* rowp = tb + (size_t)(rowt + ai * 128 + m * 16) * 512;
#pragma unroll
                    for (int bj = 0; bj < 2; ++bj) { const pg8::f32x4 v0 = acc[ai][bj][m][0], v1 = acc[ai][bj][m][1];
                        v4u w; w.x = pg8::cvt_pk_bf16(v0[0], v0[1]); w.y = pg8::cvt_pk_bf16(v0[2], v0[3]); w.z = pg8::cvt_pk_bf16(v1[0], v1[1]); w.w = pg8::cvt_pk_bf16(v1[2], v1[3]);
                        *(v4u*)(rowp + bj * 256) = w; } }
        } else {
            const bool glu = u.pn >= 12;
            unsigned char* tb = pmb + (glu ? 1048576 + (u.pn - 12) * 65536 : 524288 + (u.pn - 4) * 65536) + (wc * 32 + 8 * fq) * 2;
#pragma unroll
            for (int ai = 0; ai < 2; ++ai)
#pragma unroll
                for (int m = 0; m < 4; ++m) { unsigned char* rowp = tb + (size_t)(rowt + ai * 128 + m * 16) * 256;
                    pg8::f32x4 a0 = acc[ai][0][m][0], a1 = acc[ai][0][m][1]; const pg8::f32x4 b0 = acc[ai][1][m][0], b1 = acc[ai][1][m][1];
                    if (glu) {
#pragma unroll
                        for (int i = 0; i < 4; ++i) { a0[i] *= sigmoidf_(b0[i]); a1[i] *= sigmoidf_(b1[i]); }
                    } else { a0 = a0 * b0; a1 = a1 * b1; }
                    v4u w; w.x = pg8::cvt_pk_bf16(a0[0], a0[1]); w.y = pg8::cvt_pk_bf16(a0[2], a0[3]); w.z = pg8::cvt_pk_bf16(a1[0], a1[1]); w.w = pg8::cvt_pk_bf16(a1[2], a1[3]);
                    *(v4u*)rowp = w; }
        }
    }
};

__device__ __forceinline__ void p3_mix(const Frame& F, const Args& A) {
    LAS float* stats = (LAS float*)(F.lds + RING_OFF);
    LAS float* fin = (LAS float*)(F.lds + RING_OFF + 4096);
    const int tid = F.tid, ch = 2 * tid;
    float ca[3][2]; f32x2 cb[31];
#pragma unroll
    for (int k = 0; k < 3; ++k) { ca[k][0] = A.conv_a()[k * DCA + ch]; ca[k][1] = A.conv_a()[k * DCA + ch + 1]; }
#pragma unroll
    for (int k = 0; k < 31; ++k) cb[k] = (f32x2){A.conv_b()[k * DCA + ch], A.conv_b()[k * DCA + ch + 1]};
    const float na0 = A.norm_a()[ch], na1 = A.norm_a()[ch + 1], bb0 = A.conv_b_bias()[ch], bb1 = A.conv_b_bias()[ch + 1];
    const float lg0 = A.ln_g()[ch], lg1 = A.ln_g()[ch + 1], lb0 = A.ln_b()[ch], lb1 = A.ln_b()[ch + 1];
    const __amdgpu_buffer_rsrc_t Prs = __builtin_amdgcn_make_buffer_rsrc((void*)A.P(), 0, (int)((size_t)NTOK * PW * 2), 0x00020000);
    const __amdgpu_buffer_rsrc_t Yrs = __builtin_amdgcn_make_buffer_rsrc((void*)A.Y(), 0, (int)((size_t)NTOK * DM * 2), 0x00020000);
    const int vo = 4 * tid;
    const int voB = (tid >> 7) * 131072 + 4 * (tid & 127), voC = 524288 + (tid >> 6) * 65536 + 4 * (tid & 63), voU = voC + 524288;
#define P3_LDB(t) __builtin_amdgcn_raw_buffer_load_b32(Prs, voB, ((t) >> 8) * 1572864 + ((t) & 255) * 512, 0)
#define P3_LDC(t) __builtin_amdgcn_raw_buffer_load_b32(Prs, voC, ((t) >> 8) * 1572864 + ((t) & 255) * 256, 0)
#define P3_LDU(t) __builtin_amdgcn_raw_buffer_load_b32(Prs, voU, ((t) >> 8) * 1572864 + ((t) & 255) * 256, 0)
#define P3_ST(v, t, cb_) __builtin_amdgcn_raw_buffer_store_b32((v), Yrs, vo, (t) * 4096 + (cb_), 0)
    for (int tile = blockIdx.x; tile < NTOK / 128; tile += F.G) {
        const int t0 = tile * 128; const bool first = (t0 & (SEQ - 1)) == 0;
        f32x2 wb[32];
        wb[0] = (f32x2){0.f, 0.f}; wb[1] = (f32x2){0.f, 0.f};
#pragma unroll
        for (int s = 2; s < 32; ++s) { unsigned uu = 0u; if (!first) uu = P3_LDU(t0 - 32 + s); wb[s] = (f32x2){bf_lo(uu), bf_hi(uu)}; }
        float cm1[2], cm2[2];
        { unsigned u1 = 0u, u2 = 0u; if (!first) { u1 = P3_LDC(t0 - 1); u2 = P3_LDC(t0 - 2); }
          cm1[0] = bf_lo(u1); cm1[1] = bf_hi(u1); cm2[0] = bf_lo(u2); cm2[1] = bf_hi(u2); }
        unsigned nb[8], nc[8], nu[8];
#pragma unroll
        for (int s = 0; s < 8; ++s) { nb[s] = P3_LDB(t0 + s); nc[s] = P3_LDC(t0 + s); nu[s] = P3_LDU(t0 + s); }
        for (int blk = 0; blk < 4; ++blk) {
#pragma unroll
            for (int sub = 0; sub < 4; ++sub) {
                const int par = sub & 1;
                const int tb = t0 + 32 * blk + 8 * sub;
                unsigned pb[8], pc[8], pu[8];
#pragma unroll
                for (int s = 0; s < 8; ++s) { pb[s] = nb[s]; pc[s] = nc[s]; pu[s] = nu[s]; }
#pragma unroll
                for (int s = 0; s < 8; ++s) { nb[s] = P3_LDB(tb + 8 + s); nc[s] = P3_LDC(tb + 8 + s); nu[s] = P3_LDU(tb + 8 + s); }
                float vk[8][2];
#pragma unroll
                for (int s = 0; s < 8; ++s) {
                    const int S = 8 * sub + s;
                    const float c0 = bf_lo(pc[s]), c1 = bf_hi(pc[s]);
                    const float ya0 = bf_lo(pb[s]) * (ca[0][0] * cm2[0] + ca[1][0] * cm1[0] + ca[2][0] * c0);
                    const float ya1 = bf_hi(pb[s]) * (ca[0][1] * cm2[1] + ca[1][1] * cm1[1] + ca[2][1] * c1);
                    cm2[0] = cm1[0]; cm2[1] = cm1[1]; cm1[0] = c0; cm1[1] = c1;
                    wb[S] = (f32x2){bf_lo(pu[s]), bf_hi(pu[s])};
                    f32x2 av = (f32x2){bb0, bb1}, aw = (f32x2){0.f, 0.f};
#pragma unroll
                    for (int k = 0; k < 30; k += 2) { av = __builtin_elementwise_fma(cb[k], wb[(S + 2 + k) & 31], av); aw = __builtin_elementwise_fma(cb[k + 1], wb[(S + 3 + k) & 31], aw); }
                    av = __builtin_elementwise_fma(cb[30], wb[S], av) + aw;
                    const float a0 = av.x, a1 = av.y;
                    vk[s][0] = a0; vk[s][1] = a1;
                    float ssa = ya0 * ya0 + ya1 * ya1, s1 = a0 + a1, s2 = a0 * a0 + a1 * a1;
                    wave_sum3_dpp(ssa, s1, s2);
                    const float ra = __builtin_amdgcn_rsqf(ssa * (1.0f / 128.0f) + EPS);
                    P3_ST(cvt2bf(ya0 * ra * na0, ya1 * ra * na1), tb + s, 0);
                    if (F.lane == 0) { stats[((par * 8 + s) * 8 + F.wave) * 2 + 0] = s1; stats[((par * 8 + s) * 8 + F.wave) * 2 + 1] = s2; }
                }
                LDS_WAIT(); __builtin_amdgcn_s_barrier(); asm volatile("" ::: "memory");
                if (tid < 8) { float q1 = 0.f, q2 = 0.f;
#pragma unroll
                    for (int w = 0; w < 8; ++w) { q1 += stats[((par * 8 + tid) * 8 + w) * 2 + 0]; q2 += stats[((par * 8 + tid) * 8 + w) * 2 + 1]; }
                    const float mean = q1 * (1.0f / 1024.0f); float var = q2 * (1.0f / 1024.0f) - mean * mean; var = var > 0.f ? var : 0.f;
                    fin[(par * 8 + tid) * 2 + 0] = mean; fin[(par * 8 + tid) * 2 + 1] = __builtin_amdgcn_rsqf(var + EPS); }
                LDS_WAIT(); __builtin_amdgcn_s_barrier(); asm volatile("" ::: "memory");
#pragma unroll
                for (int s = 0; s < 8; ++s) { const float mean = fin[(par * 8 + s) * 2 + 0], rstd = fin[(par * 8 + s) * 2 + 1];
                    const float z0 = (vk[s][0] - mean) * rstd * lg0 + lb0, z1 = (vk[s][1] - mean) * rstd * lg1 + lb1;
                    P3_ST(cvt2bf(z0 * sigmoidf_(z0), z1 * sigmoidf_(z1)), tb + s, 2048); }
            }
        }
    }
#undef P3_LDB
#undef P3_LDC
#undef P3_LDU
#undef P3_ST
}

constexpr int P5_OFF_PV = 0;
constexpr int P5_OFF_RED = 24576;
constexpr int P5_OFF_PART = 25600;
constexpr int P5_OFF_LOG = 66560;
constexpr int P5_OFF_REC = 71680;
constexpr int P5_OFF_CNT = 88064;
constexpr int P5_MAXREC = 1024;
__device__ __forceinline__ void p5_params(const Frame& F, const Args& A, int b) {
    LAS float* pv = (LAS float*)(F.lds + RING_OFF + P5_OFF_PV); const float* modb = A.mod() + b * NMODC;
    for (int k = F.tid; k < DM; k += NWAVES * 64) { pv[k] = modb[2 * DM + k] * A.g_post1()[k]; pv[DM + k] = A.g_pre2()[k] * (modb[4 * DM + k] + 1.0f); pv[2 * DM + k] = modb[3 * DM + k]; }
}
#define P5_BAR() do { LDS_WAIT(); __builtin_amdgcn_s_barrier(); asm volatile("" ::: "memory"); } while (0)
__device__ __forceinline__ void p5_norm2_router(const Frame& F, const Args& A) {
    const int lane = F.lane, w = F.wave, r = lane & 15, q = lane >> 4, kb = 256 * w, ko = kb + 16 * q;
    LAS float* pv = (LAS float*)(F.lds + RING_OFF + P5_OFF_PV);
    LAS float* red1 = (LAS float*)(F.lds + RING_OFF + P5_OFF_RED); LAS float* red2 = red1 + 128;
    LAS float* part = (LAS float*)(F.lds + RING_OFF + P5_OFF_PART);
    LAS float* lg = (LAS float*)(F.lds + RING_OFF + P5_OFF_LOG);
    LAS int* rec_e = (LAS int*)(F.lds + RING_OFF + P5_OFF_REC); LAS int* rec_a = rec_e + P5_MAXREC; LAS int* rec_p = rec_a + P5_MAXREC; LAS float* rec_w = (LAS float*)(rec_p + P5_MAXREC);
    LAS int* lcnt = (LAS int*)(F.lds + RING_OFF + P5_OFF_CNT); LAS int* lbase = lcnt + 64;
    if (F.tid < 64) lcnt[F.tid] = 0;
    const int tpb = (NTOK / 16 + F.G - 1) / F.G;
    int bcur = -1, nrec = 0;
    for (int i = 0; i < tpb; ++i) {
        const int tile = (int)blockIdx.x * tpb + i; if (tile >= NTOK / 16) break;
        const int mt0 = tile * 16, b = mt0 >> 14, m = mt0 + r;
        const float* xrow = A.x() + (size_t)m * DM + ko;
        const int oidx = (mt0 >> 4) & 15;
        const bf16* otile = A.O() + (size_t)((mt0 >> 8) * 8 + w) * OTILE_PITCH + (size_t)(((oidx >> 2) & 1) * 64 * 512) + (size_t)(((oidx >> 3) * 4 + (oidx & 3)) * 2) * 512 + (size_t)r * 8;
        f32x4 xv[4][4]; v4u ov[4][2];
#pragma unroll
        for (int cg = 0; cg < 4; ++cg) {
#pragma unroll
            for (int j = 0; j < 4; ++j) xv[cg][j] = *(const f32x4*)(xrow + 64 * cg + 4 * j);
#pragma unroll
            for (int hh = 0; hh < 2; ++hh) { const int wcq = (2 * cg + (q >> 1)) & 3, fqq = 2 * (q & 1) + hh;
                ov[cg][hh] = *(const v4u*)(otile + (size_t)(wcq * 16 + (cg >> 1)) * 512 + fqq * 128); } }
        if (b != bcur) { P5_BAR(); p5_params(F, A, b); bcur = b; P5_BAR(); }
        float so = 0.f;
#pragma unroll
        for (int cg = 0; cg < 4; ++cg)
#pragma unroll
            for (int hh = 0; hh < 2; ++hh) { const v4u p = ov[cg][hh]; const f32x4 va = (f32x4){bf_lo(p.x), bf_hi(p.x), bf_lo(p.y), bf_hi(p.y)}, vb = (f32x4){bf_lo(p.z), bf_hi(p.z), bf_lo(p.w), bf_hi(p.w)};
                so += dot4(va, va) + dot4(vb, vb); }
        so += __shfl_xor(so, 16); so += __shfl_xor(so, 32);
        if (q == 0) red1[w * 16 + r] = so;
        P5_BAR();
        float to = 0.f;
#pragma unroll
        for (int ww = 0; ww < 8; ++ww) to += red1[ww * 16 + r];
        const float ro = 1.0f / sqrtf(to * (1.0f / DM) + EPS);
        bf16* x1row = A.X1() + (size_t)m * DM + ko; float sx = 0.f;
#pragma unroll
        for (int cg = 0; cg < 4; ++cg)
#pragma unroll
            for (int hh = 0; hh < 2; ++hh) { const v4u p = ov[cg][hh]; const f32x4 va = (f32x4){bf_lo(p.x), bf_hi(p.x), bf_lo(p.y), bf_hi(p.y)}, vb = (f32x4){bf_lo(p.z), bf_hi(p.z), bf_lo(p.w), bf_hi(p.w)};
                const f32x4 a1a = *(const LAS f32x4*)(pv + ko + 64 * cg + 8 * hh), a1b = *(const LAS f32x4*)(pv + ko + 64 * cg + 8 * hh + 4);
                const f32x4 x1a = xv[cg][2 * hh] + a1a * (va * ro), x1b = xv[cg][2 * hh + 1] + a1b * (vb * ro);
                xv[cg][2 * hh] = x1a; xv[cg][2 * hh + 1] = x1b;
                *(v4u*)(x1row + 64 * cg + 8 * hh) = (v4u){cvt2bf(x1a.x, x1a.y), cvt2bf(x1a.z, x1a.w), cvt2bf(x1b.x, x1b.y), cvt2bf(x1b.z, x1b.w)}; sx += dot4(x1a, x1a) + dot4(x1b, x1b); }
        sx += __shfl_xor(sx, 16); sx += __shfl_xor(sx, 32);
        if (q == 0) red2[w * 16 + r] = sx;
        P5_BAR();
        float tx = 0.f;
#pragma unroll
        for (int ww = 0; ww < 8; ++ww) tx += red2[ww * 16 + r];
        const float r1 = 1.0f / sqrtf(tx * (1.0f / DM) + EPS);
        unsigned char* hrow = A.H8() + (size_t)m * DM + ko;
        const __amdgpu_buffer_rsrc_t wrs = __builtin_amdgcn_make_buffer_rsrc((void*)A.WR(), 0, 8 * 8 * 5 * 1024, 0x00020000);
#define P5_LDB(c, f) __builtin_bit_cast(f16x8_, __builtin_amdgcn_raw_buffer_load_b128(wrs, lane * 16, ((w * 8 + (c)) * 5 + (f)) * 1024, 0))
        f32x4 acc[5];
#pragma unroll
        for (int nf = 0; nf < 5; ++nf) acc[nf] = (f32x4){0.f, 0.f, 0.f, 0.f};
        f16x8_ bq[5], b1[5], b2[5];
#pragma unroll
        for (int f = 0; f < 5; ++f) { b1[f] = P5_LDB(0, f); b2[f] = P5_LDB(1, f); }
#pragma unroll
        for (int cg = 0; cg < 4; ++cg) {
            unsigned h8[4];
#pragma unroll
            for (int hh = 0; hh < 2; ++hh) {
                const int c = 2 * cg + hh;
#pragma unroll
                for (int f = 0; f < 5; ++f) { bq[f] = b1[f]; b1[f] = b2[f]; }
                if (c + 2 < 8) {
#pragma unroll
                    for (int f = 0; f < 5; ++f) b2[f] = P5_LDB(c + 2, f);
                }
                const f32x4 a2a = *(const LAS f32x4*)(pv + DM + ko + 64 * cg + 8 * hh), a2b = *(const LAS f32x4*)(pv + DM + ko + 64 * cg + 8 * hh + 4);
                const f32x4 a3a = *(const LAS f32x4*)(pv + 2 * DM + ko + 64 * cg + 8 * hh), a3b = *(const LAS f32x4*)(pv + 2 * DM + ko + 64 * cg + 8 * hh + 4);
                const f32x4 ha = xv[cg][2 * hh] * r1 * a2a + a3a, hb = xv[cg][2 * hh + 1] * r1 * a2b + a3b;
                h8[2 * hh] = pk4_fp8(ha.x * SC_H, ha.y * SC_H, ha.z * SC_H, ha.w * SC_H); h8[2 * hh + 1] = pk4_fp8(hb.x * SC_H, hb.y * SC_H, hb.z * SC_H, hb.w * SC_H);
                const unsigned h0 = pkh2(ha.x, ha.y), h1 = pkh2(ha.z, ha.w), h2 = pkh2(hb.x, hb.y), h3 = pkh2(hb.z, hb.w);
                const unsigned l0 = pkh2(ha.x - h_lo(h0), ha.y - h_hi(h0)), l1 = pkh2(ha.z - h_lo(h1), ha.w - h_hi(h1)), l2 = pkh2(hb.x - h_lo(h2), hb.y - h_hi(h2)), l3 = pkh2(hb.z - h_lo(h3), hb.w - h_hi(h3));
                const f16x8_ ahi = __builtin_bit_cast(f16x8_, (v4u){h0, h1, h2, h3}), alo = __builtin_bit_cast(f16x8_, (v4u){l0, l1, l2, l3});
#pragma unroll
                for (int nf = 0; nf < 5; ++nf) { acc[nf] = __builtin_amdgcn_mfma_f32_16x16x32_f16(ahi, bq[nf], acc[nf], 0, 0, 0); acc[nf] = __builtin_amdgcn_mfma_f32_16x16x32_f16(alo, bq[nf], acc[nf], 0, 0, 0); }
            }
            *(v4u*)(hrow + 64 * cg) = (v4u){h8[0], h8[1], h8[2], h8[3]};
        }
#undef P5_LDB
#pragma unroll
        for (int nf = 0; nf < 5; ++nf)
#pragma unroll
            for (int ii = 0; ii < 4; ++ii) part[(w * 16 + 4 * q + ii) * 80 + 16 * nf + r] = acc[nf][ii];
        P5_BAR();
        for (int p = F.tid; p < 16 * 80; p += NWAVES * 64) { const int tok = p / 80, n = p - tok * 80; float sum = 0.f;
#pragma unroll
            for (int ww = 0; ww < 8; ++ww) sum += part[(ww * 16 + tok) * 80 + n];
            lg[p] = sum; }
        P5_BAR();
        if (F.tid < 16) {
            const LAS float* L = lg + F.tid * 80;
            float ac[8];
#pragma unroll
            for (int n = 0; n < 8; ++n) ac[n] = L[n] + A.b_rg()[n];
            int g = 0; float mx = ac[0];
#pragma unroll
            for (int n = 1; n < 8; ++n) if (ac[n] > mx) { mx = ac[n]; g = n; }
            float se = 0.f;
#pragma unroll
            for (int n = 0; n < 8; ++n) se += expf(ac[n] - mx);
            const float pg = 1.0f / se;
            float af[8];
#pragma unroll
            for (int n = 0; n < 8; ++n) af[n] = L[8 + 8 * g + n] + A.b_re()[g * 8 + n];
            int i0 = 0; float v0 = af[0];
#pragma unroll
            for (int n = 1; n < 8; ++n) if (af[n] > v0) { v0 = af[n]; i0 = n; }
            int i1 = -1; float v1 = 0.f;
#pragma unroll
            for (int n = 0; n < 8; ++n) if (n != i0 && (i1 < 0 || af[n] > v1)) { v1 = af[n]; i1 = n; }
            const float ee = expf(v1 - v0), w0 = 1.0f / (1.0f + ee), w1 = ee / (1.0f + ee);
            const int e0 = g * 8 + i0, e1 = g * 8 + i1, mm = mt0 + F.tid, ix = nrec + 2 * F.tid;
            rec_e[ix] = e0; rec_a[ix] = 2 * mm; rec_w[ix] = pg * w0; rec_p[ix] = __hip_atomic_fetch_add(lcnt + e0, 1, __ATOMIC_RELAXED, __HIP_MEMORY_SCOPE_WORKGROUP);
            rec_e[ix + 1] = e1; rec_a[ix + 1] = 2 * mm + 1; rec_w[ix + 1] = pg * w1; rec_p[ix + 1] = __hip_atomic_fetch_add(lcnt + e1, 1, __ATOMIC_RELAXED, __HIP_MEMORY_SCOPE_WORKGROUP);
        }
        nrec += 32;
    }
    P5_BAR();
    if (F.tid < 64) { const int n = lcnt[F.tid]; lbase[F.tid] = n > 0 ? (int)__hip_atomic_fetch_add(A.ctl() + CW_CNT + 64 * F.tid, (unsigned)n, RLX_AGENT) : 0; }
    P5_BAR();
    for (int ix = F.tid; ix < nrec; ix += NWAVES * 64) { const int e = rec_e[ix], slot = lbase[e] + rec_p[ix];
        A.lista()[(size_t)e * LISTCAP + slot] = (int)((unsigned)rec_a[ix] | (cvt2bf(0.f, rec_w[ix]) & 0xffff0000u)); }
}
#undef P5_BAR

struct MUnit { int e, mt, nt, cnt, prow, half; };
constexpr int MOE_MAXU = 24;
__device__ __forceinline__ void moe_tables(const Frame& F, const Args& A) {
    LAS int* T = (LAS int*)(F.lds + TAB_OFF);
    if (F.tid < 64) {
        const int c = (int)__hip_atomic_load(A.ctl() + CW_CNT + 64 * F.tid, RLX_AGENT), full = c >> 8, rem = c & 255;
        int rows = ((c + 255) >> 8) << 8, ua = (full + (rem > 128 ? 1 : 0)) * 8, ub = (rem > 0 && rem <= 128) ? 8 : 0;
        const int rows0 = rows, ua0 = ua, ub0 = ub;
#pragma unroll
        for (int o = 1; o < 64; o <<= 1) { const int r1 = __shfl_up(rows, o), a1 = __shfl_up(ua, o), b1 = __shfl_up(ub, o); if (F.lane >= o) { rows += r1; ua += a1; ub += b1; } }
        T[F.tid] = c; T[64 + F.tid] = rows - rows0; T[128 + F.tid] = ua - ua0; T[200 + F.tid] = ub - ub0;
        if (F.tid == 63) { T[128 + 64] = ua; T[200 + 64] = ub; } }
    __syncthreads();
    const int G = F.G, bx = (int)blockIdx.x, rk = (G % 8 == 0) ? (bx % 8) * (G / 8) + bx / 8 : bx;
    const int UA = T[192], UB = T[264], nu = (UA + UB > rk) ? (UA + UB - rk + G - 1) / G : 0;
    if (F.tid == 0) T[270] = nu < MOE_MAXU ? nu : MOE_MAXU;
    if (F.tid < MOE_MAXU && F.tid < nu) {
        const int p = F.tid * G + rk; int e = 0, mt, nt, half;
        if (p < UA) { for (int q = 1; q < NEXP; ++q) if (p >= T[128 + q]) e = q; const int l = p - T[128 + e]; mt = l >> 3; nt = l & 7; half = 0; }
        else { const int pp = p - UA; for (int q = 1; q < NEXP; ++q) if (pp >= T[200 + q]) e = q; mt = T[e] >> 8; nt = (pp - T[200 + e]) & 7; half = 1; }
        LAS int* d = T + 272 + 4 * F.tid; d[0] = e; d[1] = mt; d[2] = nt; d[3] = half; }
    __syncthreads();
}
struct MoeSched {
    const LAS int* T;
    __device__ __forceinline__ bool next(int i, MUnit& u) const {
        if (i >= T[270]) return false;
        const LAS int* d = T + 272 + 4 * i; const int e = d[0], mt = d[1];
        u.e = __builtin_amdgcn_readfirstlane(e); u.mt = __builtin_amdgcn_readfirstlane(mt); u.nt = __builtin_amdgcn_readfirstlane(d[2]); u.half = __builtin_amdgcn_readfirstlane(d[3]);
        u.cnt = __builtin_amdgcn_readfirstlane(T[e]); u.prow = __builtin_amdgcn_readfirstlane(T[64 + e] + 256 * mt); return true;
    }
};
typedef int v4i_ __attribute__((ext_vector_type(4)));
typedef int v8i_ __attribute__((ext_vector_type(8)));
struct EpiGateUp8 {
    static constexpr bool HAS_PRE = false;
    unsigned char* HID;
    __device__ __forceinline__ void pre(const MUnit&, int, int, int (&)[8]) const {}
    __device__ __forceinline__ void operator()(const pg8::f32x4 (&acc)[2][2][4][2], const MUnit& u, int wr, int wc, int fr, int fq, const int (&)[8]) const {
        unsigned char* tile = HID + ((size_t)(u.prow >> 8) * 8 + u.nt) * 32768; const int rowt = wr * 64 + fr, colt = wc * 32 + 8 * fq; const float sc = 1.0f / (SC_H * SC_WGU);
#pragma unroll
        for (int ai = 0; ai < 2; ++ai) { if (ai == 1 && u.half) break;
#pragma unroll
            for (int m = 0; m < 4; ++m) { unsigned char* rowp = tile + (size_t)(rowt + ai * 128 + m * 16) * 128 + colt;
                pg8::f32x4 a0 = acc[ai][0][m][0] * sc, a1 = acc[ai][0][m][1] * sc; const pg8::f32x4 b0 = acc[ai][1][m][0] * (sc * SC_HID), b1 = acc[ai][1][m][1] * (sc * SC_HID);
#pragma unroll
                for (int i = 0; i < 4; ++i) { a0[i] = a0[i] * sigmoidf_(a0[i]) * b0[i]; a1[i] = a1[i] * sigmoidf_(a1[i]) * b1[i]; }
                *(v2u*)rowp = (v2u){pk4_fp8(a0[0], a0[1], a0[2], a0[3]), pk4_fp8(a1[0], a1[1], a1[2], a1[3])}; } }
    }
};
struct EpiDown8 {
    static constexpr bool HAS_PRE = true;
    bf16* YD; const int* lrec;
    __device__ __forceinline__ void pre(const MUnit& u, int wr, int fr, int (&pa)[8]) const {
#pragma unroll
        for (int ai = 0; ai < 2; ++ai)
#pragma unroll
            for (int m = 0; m < 4; ++m) { const int s = 256 * u.mt + ai * 128 + wr * 64 + m * 16 + fr; const int sc = s < u.cnt ? s : 0;
                pa[ai * 4 + m] = lrec[(size_t)u.e * LISTCAP + sc]; }
    }
    __device__ __forceinline__ void operator()(const pg8::f32x4 (&acc)[2][2][4][2], const MUnit& u, int wr, int wc, int fr, int fq, const int (&pa)[8]) const {
        const int col0 = u.nt * 256 + wc * 32 + 8 * fq;
#pragma unroll
        for (int ai = 0; ai < 2; ++ai)
#pragma unroll
            for (int m = 0; m < 4; ++m) { const int s = 256 * u.mt + ai * 128 + wr * 64 + m * 16 + fr;
                if (s < u.cnt) { const unsigned rc = (unsigned)pa[ai * 4 + m]; const int a = (int)(rc & 0xffffu); const float wgt = bf_hi(rc) * (1.0f / (SC_HID * SC_WD));
                    bf16* rowp = YD + (size_t)a * DM + col0;
#pragma unroll
                    for (int bj = 0; bj < 2; ++bj) { const pg8::f32x4 v0 = acc[ai][bj][m][0] * wgt, v1 = acc[ai][bj][m][1] * wgt;
                        v4u w; w.x = pg8::cvt_pk_bf16(v0[0], v0[1]); w.y = pg8::cvt_pk_bf16(v0[2], v0[3]); w.z = pg8::cvt_pk_bf16(v1[0], v1[1]); w.w = pg8::cvt_pk_bf16(v1[2], v1[3]);
                        *(v4u*)(rowp + bj * 128) = w; } } }
    }
};

template <class Epi, bool GATHER>
__device__ __forceinline__ void gemm_phase_moe8(LAS unsigned char* lds, const unsigned char* Abase, const unsigned char* Wbase, const int KB, const int* lista, const MoeSched& S, const Epi& E, const int wave_id) {
    using namespace pg8;
    int tid_ = wave_id * 64 + lane_id_fresh();
    const int tid = tid_, wid = __builtin_amdgcn_readfirstlane(tid >> 6), lane = tid & 63, wr = wid >> 2, wc = wid & 3, fr = lane & 15, fq = lane >> 4;
    const int nt = KB / 128;
    int Rr[2], Cc[2]; unsigned voffB[2];
#pragma unroll
    for (int i = 0; i < 2; ++i) { int R, C; stage_rc(tid * 16 + i * 8192, R, C); const int Rb = (R & ~31) + perm32(R & 31); Rr[i] = R; Cc[i] = C; voffB[i] = (unsigned)(Rb * 128 + C * 2); }
    const size_t kstep = GATHER ? 128 : 32768;
    const size_t kstepB = (size_t)2048 * 128, hstep = (size_t)HALF * 128;
    const unsigned ldsw = (unsigned)wid * 1024u;
    const int aoff = lds_byte(wr * 64 + fr, fq * 8), boff = lds_byte(wc * 32 + fr, fq * 8);
#define PG8_SA(b, h) (((b) * 2 + (h)) * HTB)
#define PG8_SB(b, h) ((4 + (b) * 2 + (h)) * HTB)
#define PG8_STAGE(bufoff, gbase, voff) do { _Pragma("unroll") for (int _i = 0; _i < 2; ++_i) \
        __builtin_amdgcn_global_load_lds((const unsigned*)((const char*)(gbase) + (voff)[_i]), (PG8_LAS unsigned*)(lds + (bufoff) + ldsw + _i * 8192), 16, 0, 0); } while (0)
#define PG8_STAGE2(bufoff, gbase, o0, o1) do { \
        __builtin_amdgcn_global_load_lds((const unsigned*)((const char*)(gbase) + (o0)), (PG8_LAS unsigned*)(lds + (bufoff) + ldsw), 16, 0, 0); \
        __builtin_amdgcn_global_load_lds((const unsigned*)((const char*)(gbase) + (o1)), (PG8_LAS unsigned*)(lds + (bufoff) + ldsw + 8192), 16, 0, 0); } while (0)
#define PG8_LDA(dst, b, h) do { _Pragma("unroll") for (int m = 0; m < 4; ++m) dst[m] = PG8_CAT(*(const PG8_LAS v4i_*)(lds + PG8_SA(b, h) + aoff + m * 2048), *(const PG8_LAS v4i_*)(lds + PG8_SA(b, h) + aoff + m * 2048 + 1024)); } while (0)
#define PG8_LDB(dst, b, h) do { _Pragma("unroll") for (int n = 0; n < 2; ++n) dst[n] = PG8_CAT(*(const PG8_LAS v4i_*)(lds + PG8_SB(b, h) + boff + n * 2048), *(const PG8_LAS v4i_*)(lds + PG8_SB(b, h) + boff + n * 2048 + 1024)); } while (0)
#define PG8_MMA(ai, bj, At, Bt) do { __builtin_amdgcn_s_setprio(1); _Pragma("unroll") for (int m = 0; m < 4; ++m) _Pragma("unroll") for (int n = 0; n < 2; ++n) \
        asm volatile("v_mfma_f32_16x16x128_f8f6f4 %0, %1, %2, %0" : "+v"(acc[ai][bj][m][n]) : "v"(Bt[n]), "v"(At[m])); __builtin_amdgcn_s_setprio(0); } while (0)
#define PG8_MFMA_DRAIN() asm volatile("s_nop 15\n\ts_nop 15" ::: "memory")
#define PG8_CAT(x, y) __builtin_shufflevector((x), (y), 0, 1, 2, 3, 4, 5, 6, 7)
#define PG8_WAIT_V(n) asm volatile("s_waitcnt vmcnt(" #n ")" ::: "memory")
#define PG8_WAIT_L(n) asm volatile("s_waitcnt lgkmcnt(" #n ")" ::: "memory")
#define PG8_BAR __builtin_amdgcn_s_barrier()
#define PG8_SCHED __builtin_amdgcn_sched_barrier(0)
#define MOE_ROWOFF(dst, u, h, i) do { const int _s = 256 * (u).mt + 128 * (h) + Rr[i]; \
        if (GATHER) { int _tok = 0; if (_s < (u).cnt) _tok = (lista[(size_t)(u).e * LISTCAP + _s] & 0xffff) >> 1; dst = (unsigned)_tok * (unsigned)KB + (unsigned)(Cc[i] * 2); } \
        else dst = (unsigned)((u).prow >> 8) * (unsigned)(KB * 256) + (unsigned)(128 * (h) + Rr[i]) * 128u + (unsigned)(Cc[i] * 2); } while (0)
    MUnit cur, nxt; int ui = 0;
    if (!S.next(0, cur)) return;
    f32x4 acc[2][2][4][2];
#pragma unroll
    for (int a = 0; a < 2; ++a)
#pragma unroll
        for (int b = 0; b < 2; ++b)
#pragma unroll
            for (int m = 0; m < 4; ++m)
#pragma unroll
                for (int n = 0; n < 2; ++n) acc[a][b][m][n] = (f32x4){0.f, 0.f, 0.f, 0.f};
    v8i_ At[4], B0[2], B1[2];
    unsigned c00, c01, c10, c11, n00, n01, n10, n11;
    MOE_ROWOFF(c00, cur, 0, 0); MOE_ROWOFF(c01, cur, 0, 1); MOE_ROWOFF(c10, cur, 1, 0); MOE_ROWOFF(c11, cur, 1, 1);
    const char* const cA = (const char*)Abase;
    const char* cB = (const char*)Wbase + (size_t)cur.e * 2048 * KB + (size_t)cur.nt * 32768;
    PG8_STAGE(PG8_SB(0, 0), cB, voffB); PG8_STAGE(PG8_SB(0, 1), cB + hstep, voffB); PG8_STAGE2(PG8_SA(0, 0), cA, c00, c01); PG8_STAGE2(PG8_SA(0, 1), cA, c10, c11);
    if (wr == 1) PG8_BAR;
    PG8_WAIT_V(2); PG8_BAR;
    PG8_STAGE(PG8_SB(1, 0), cB + kstepB, voffB); PG8_STAGE2(PG8_SA(1, 0), cA + kstep, c00, c01); PG8_STAGE(PG8_SB(1, 1), cB + hstep + kstepB, voffB);
    PG8_WAIT_V(6); PG8_BAR;
    for (;;) {
        const bool has_next = S.next(ui + 1, nxt);
        const char* nB = cB;
        n00 = c00; n01 = c01; n10 = c10; n11 = c11;
        if (has_next) { MOE_ROWOFF(n00, nxt, 0, 0); MOE_ROWOFF(n01, nxt, 0, 1); MOE_ROWOFF(n10, nxt, 1, 0); MOE_ROWOFF(n11, nxt, 1, 1);
            nB = (const char*)Wbase + (size_t)nxt.e * 2048 * KB + (size_t)nxt.nt * 32768; }
        int pa[8];
        const bool chalf = cur.half != 0;
        for (int t = 0; t < nt; t += 2) {
            const bool last = (t == nt - 2);
            const char* a1 = cA + (size_t)(t + 1) * kstep;
            const char* a2 = last ? cA : cA + (size_t)(t + 2) * kstep; const char* b2 = last ? nB : cB + (size_t)(t + 2) * kstepB;
            const char* a3 = a2 + kstep; const char* b3 = b2 + kstepB;
            unsigned x00 = c00, x01 = c01, x10 = c10, x11 = c11;
            if (last) { if (Epi::HAS_PRE) E.pre(cur, wr, fr, pa);
                asm volatile("" : "+v"(n00), "+v"(n01), "+v"(n10), "+v"(n11));
                x00 = n00; x01 = n01; x10 = n10; x11 = n11; }
            PG8_LDB(B0, 0, 0); PG8_LDB(B1, 0, 1); PG8_SCHED; PG8_LDA(At, 0, 0); PG8_STAGE2(PG8_SA(1, 1), a1, c10, c11);
            PG8_WAIT_V(8); PG8_WAIT_L(0); PG8_BAR; PG8_MMA(0, 0, At, B0); PG8_MMA(0, 1, At, B1); PG8_BAR; PG8_SCHED;
            if (!chalf) PG8_LDA(At, 0, 1);
            PG8_STAGE(PG8_SB(0, 0), b2, voffB); PG8_STAGE(PG8_SB(0, 1), b2 + hstep, voffB); PG8_STAGE2(PG8_SA(0, 0), a2, x00, x01);
            PG8_WAIT_V(8); PG8_WAIT_L(0); PG8_BAR; if (!chalf) { PG8_MMA(1, 0, At, B0); PG8_MMA(1, 1, At, B1); } PG8_BAR; PG8_SCHED;
            PG8_LDB(B0, 1, 0); PG8_LDB(B1, 1, 1); PG8_SCHED; PG8_LDA(At, 1, 0); PG8_STAGE2(PG8_SA(0, 1), a2, x10, x11);
            PG8_WAIT_V(8); PG8_WAIT_L(0); PG8_BAR; PG8_MMA(0, 0, At, B0); PG8_MMA(0, 1, At, B1); PG8_BAR; PG8_SCHED;
            if (!chalf) PG8_LDA(At, 1, 1);
            PG8_STAGE(PG8_SB(1, 0), b3, voffB); PG8_STAGE(PG8_SB(1, 1), b3 + hstep, voffB); PG8_STAGE2(PG8_SA(1, 0), a3, x00, x01);
            PG8_WAIT_V(8); PG8_WAIT_L(0); PG8_BAR; if (!chalf) { PG8_MMA(1, 0, At, B0); PG8_MMA(1, 1, At, B1); } PG8_BAR; PG8_SCHED;
        }
        if (wr == 0) PG8_BAR;
        PG8_MFMA_DRAIN();
        E(acc, cur, wr, wc, fr, fq, pa);
        if (!has_next) break;
#pragma unroll
        for (int a = 0; a < 2; ++a)
#pragma unroll
            for (int b = 0; b < 2; ++b)
#pragma unroll
                for (int m = 0; m < 4; ++m)
#pragma unroll
                    for (int n = 0; n < 2; ++n) acc[a][b][m][n] = (f32x4){0.f, 0.f, 0.f, 0.f};
        cur = nxt; cB = nB; c00 = n00; c01 = n01; c10 = n10; c11 = n11; ++ui;
        if (wr == 1) PG8_BAR;
    }
    PG8_WAIT_V(0);
    PG8_BAR;
#undef MOE_ROWOFF
#undef PG8_SA
#undef PG8_SB
#undef PG8_STAGE
#undef PG8_STAGE2
#undef PG8_LDA
#undef PG8_LDB
#undef PG8_MMA
#undef PG8_MFMA_DRAIN
#undef PG8_CAT
#undef PG8_WAIT_V
#undef PG8_WAIT_L
#undef PG8_BAR
#undef PG8_SCHED
}

__device__ __forceinline__ void p8_row_load(const Args& A, int m, int lane, f32x4 (&xv)[8], f32x4 (&yv)[8]) {
    const v2u* xr = (const v2u*)(A.X1() + (size_t)m * DM) + lane;
    const v2u* y0 = (const v2u*)(A.YD() + (size_t)(2 * m) * DM) + lane;
    const v2u* y1 = (const v2u*)(A.YD() + (size_t)(2 * m + 1) * DM) + lane;
#pragma unroll
    for (int j = 0; j < 8; ++j) { const v2u xx = xr[64 * j]; xv[j] = (f32x4){bf_lo(xx.x), bf_hi(xx.x), bf_lo(xx.y), bf_hi(xx.y)}; const v2u p = y0[64 * j], q = y1[64 * j];
        yv[j] = (f32x4){bf_lo(p.x) + bf_lo(q.x), bf_hi(p.x) + bf_hi(q.x), bf_lo(p.y) + bf_lo(q.y), bf_hi(p.y) + bf_hi(q.y)}; }
}
__device__ __forceinline__ void p8_row_finish(const Args& A, int m, int lane, const f32x4 (&xv)[8], const f32x4 (&yv)[8], const f32x4 (&gg)[8]) {
    float s = 0.f;
#pragma unroll
    for (int j = 0; j < 8; ++j) s += dot4(yv[j], yv[j]);
    const float r = 1.0f / sqrtf(wave_sum(s) * (1.0f / DM) + EPS);
    f32x4* outr = (f32x4*)(A.out() + (size_t)m * DM) + lane;
#pragma unroll
    for (int j = 0; j < 8; ++j) outr[64 * j] = xv[j] + gg[j] * (yv[j] * r);
}
__device__ __forceinline__ void p8_final(const Frame& F, const Args& A) {
    const int gw = F.vcu * NWAVES + F.wave, NGW = F.G * NWAVES, lane = F.lane;
    f32x4 gg[8]; int bcur = -1;
    for (int m0 = gw; m0 < NTOK; m0 += 2 * NGW) {
        const int m1 = m0 + NGW; const bool has1 = (m1 < NTOK) && ((m1 >> 14) == (m0 >> 14));
        f32x4 xa[8], ya[8], xb[8], yb[8];
        p8_row_load(A, m0, lane, xa, ya);
        p8_row_load(A, has1 ? m1 : m0, lane, xb, yb);
        if ((m0 >> 14) != bcur) { bcur = m0 >> 14; const f32x4* gp = (const f32x4*)A.g_post2() + lane; const f32x4* g2 = (const f32x4*)(A.mod() + bcur * NMODC + 5 * DM) + lane;
#pragma unroll
            for (int j = 0; j < 8; ++j) gg[j] = gp[64 * j] * g2[64 * j]; }
        p8_row_finish(A, m0, lane, xa, ya, gg);
        if (has1) p8_row_finish(A, m1, lane, xb, yb, gg);
        else if (m1 < NTOK) { m0 -= NGW; }
    }
}
#ifndef PHMASK
#define PHMASK 511
#endif
#ifndef GEMM2_SHARE
#define GEMM2_SHARE 27
#endif
#ifndef REPMASK
#define REPMASK 0
#endif
#define REPS(k) (((REPMASK >> (k)) & 1) ? 2 : 1)

__global__ void __launch_bounds__(NWAVES * 64, 2) mk_fwd(Args args) {
    extern __shared__ __attribute__((aligned(16))) unsigned char lds[];
    Frame F;
    F.lds = (LAS unsigned char*)lds;
    F.tid = threadIdx.x; F.lane = F.tid & 63; F.wave = __builtin_amdgcn_readfirstlane(F.tid >> 6);
    F.G = gridDim.x; { const int bx = blockIdx.x; F.vcu = (F.G % 8 == 0) ? (bx % 8) * (F.G / 8) + bx / 8 : bx; }
    const Args& A = args;
    for (int u = F.tid; u < (LDS_BYTES - LDSCTL_OFF) / 4; u += NWAVES * 64) ((LAS unsigned*)(F.lds + LDSCTL_OFF))[u] = 0u;
    __syncthreads();
    XcdBarrier bar = xcd_barrier_post(A.ctl() + CW_BAR, (volatile LAS unsigned*)(F.lds + LDSCTL_OFF));

#if PHMASK & 1
    p0_ada(phase_frame(F), A); p0_router_weights(phase_frame(F), A); p0_weights(phase_frame(F), A);
    if (REPS(0) == 2) { __syncthreads(); p0_ada(phase_frame(F), A); p0_weights(phase_frame(F), A); }
#endif
    xcd_barrier(bar, F.wave);
#if PHMASK & 2
    p1_norm1(phase_frame(F), A);
    if (REPS(1) == 2) p1_norm1(phase_frame(F), A);
#endif
    xcd_barrier(bar, F.wave);
#if PHMASK & 4
    {
        const int NG2 = (F.G % 8 == 0 && F.G >= 64) ? (F.G / 8 * GEMM2_SHARE / 32) * 8 : F.G;
        if ((int)blockIdx.x < NG2) {
            pg8::Gemm g{A.H(), A.WIN(), NTOK, DINP, DM}; pg8::StaticOrder S; S.init(NTOK, DINP, NG2, (int)blockIdx.x);
            EpiInProj E{A.P()};
            pg8::gemm_phase<EpiInProj, pg8::StaticOrder, true, true>(F.lds + RING_OFF, g, S, E, F.wave);
            if (threadIdx.x == 0) __hip_atomic_fetch_add(A.ctl() + CW_DONE, 1u, RLX_AGENT);
        }
        expert_worker(phase_frame(F), A, (unsigned)NG2); }
    if (REPS(2) == 2) {   pg8::Gemm g{A.H(), A.WIN(), NTOK, DINP, DM}; pg8::StaticOrder S; S.init(NTOK, DINP, F.G, (int)blockIdx.x);
        EpiInProj E{A.P()};
        pg8::gemm_phase<EpiInProj, pg8::StaticOrder, true, true>(F.lds + RING_OFF, g, S, E, F.wave); }
#endif
    xcd_barrier(bar, F.wave);
#if PHMASK & 8
    p3_mix(phase_frame(F), A);
    if (REPS(3) == 2) p3_mix(phase_frame(F), A);
#endif
    xcd_barrier(bar, F.wave);
#if PHMASK & 16
    {   pg8::Gemm g{A.Y(), A.WOUT(), NTOK, DM, DM}; pg8::StaticOrder S; S.init(NTOK, DM, F.G, (int)blockIdx.x);
        EpiStoreFrag E{A.O(), DM / 256};
        pg8::gemm_phase<EpiStoreFrag, pg8::StaticOrder, true, true>(F.lds + RING_OFF, g, S, E, F.wave); }
    if (REPS(4) == 2) {   pg8::Gemm g{A.Y(), A.WOUT(), NTOK, DM, DM}; pg8::StaticOrder S; S.init(NTOK, DM, F.G, (int)blockIdx.x);
        EpiStoreFrag E{A.O(), DM / 256};
        pg8::gemm_phase<EpiStoreFrag, pg8::StaticOrder, true, true>(F.lds + RING_OFF, g, S, E, F.wave); }
#endif
    xcd_barrier(bar, F.wave);
#if PHMASK & 32
    p5_norm2_router(phase_frame(F), A);
    __syncthreads();
    expert_worker(phase_frame(F), A, 0u);
#endif
    xcd_barrier(bar, F.wave);
    moe_tables(phase_frame(F), A);
    MoeSched MS; MS.T = (const LAS int*)(F.lds + TAB_OFF);
#if PHMASK & 64
#ifdef REP6LOOP
    for (int rep = 0; rep < 2; ++rep)
#endif
    {   EpiGateUp8 E{A.HID()};
        gemm_phase_moe8<EpiGateUp8, true>(F.lds + RING_OFF, A.H8(), A.WGU(), DM, A.lista(), MS, E, F.wave); }
#endif
    xcd_barrier(bar, F.wave);
#if PHMASK & 128
#ifdef REP7LOOP
    for (int rep = 0; rep < 2; ++rep)
#endif
    {   EpiDown8 E{A.YD(), A.lista()};
        gemm_phase_moe8<EpiDown8, false>(F.lds + RING_OFF, A.HID(), A.WD(), DEXP, A.lista(), MS, E, F.wave); }
#endif
    xcd_barrier(bar, F.wave);
#if PHMASK & 256
    p8_final(phase_frame(F), A);
#endif
}

extern "C" void kernel_launch(void* const* d_in, const int* in_sizes, int n_in, void* d_out, int out_size, void* d_ws, size_t ws_size, hipStream_t stream) {
    static int grid = 0;
    if (grid == 0) {
        if (n_in != 23 || in_sizes[0] != NTOK * DM || out_size != NTOK * DM || ws_size < WS_END) { fprintf(stderr, "kernel_launch: unexpected shapes (n_in %d, in0 %d, out %d, ws %zu)\n", n_in, n_in > 0 ? in_sizes[0] : -1, out_size, ws_size); grid = -1; return; }
        int dev = 0, cus = 0, per_cu = 0;
        if (hipGetDevice(&dev) != hipSuccess || hipDeviceGetAttribute(&cus, hipDeviceAttributeMultiprocessorCount, dev) != hipSuccess) { grid = -1; return; }
        if (hipFuncSetAttribute((const void*)mk_fwd, hipFuncAttributeMaxDynamicSharedMemorySize, LDS_BYTES) != hipSuccess) { fprintf(stderr, "kernel_launch: hipFuncSetAttribute failed\n"); grid = -1; return; }
        if (hipOccupancyMaxActiveBlocksPerMultiprocessor(&per_cu, (const void*)mk_fwd, NWAVES * 64, LDS_BYTES) != hipSuccess || per_cu < 1) { fprintf(stderr, "kernel_launch: occupancy query says %d\n", per_cu); }
        (void)hipGetLastError();
        grid = cus;
    }
    if (grid < 0) return;
    if (hipMemsetAsync((char*)d_ws + WS_CTL, 0, CTL_ZERO_BYTES, stream) != hipSuccess) return;
    Args a{};
    for (int i = 0; i < 23; ++i) a.in[i] = (const float*)d_in[i];
    a.out_ = (float*)d_out; a.ws = (unsigned char*)d_ws;
    hipLaunchKernelGGL(mk_fwd, dim3(grid), dim3(NWAVES * 64), LDS_BYTES, stream, a);
}
```

```cpp
#include <hip/hip_runtime.h>
#include <cstdio>
#include <cstdint>
#define GEMM2_SHARE 25
namespace pg8 {
#define PG8_LAS __attribute__((address_space(3)))
typedef unsigned short bf16_t;
typedef short bf16x8 __attribute__((ext_vector_type(8)));
typedef float f32x4 __attribute__((ext_vector_type(4)));
typedef unsigned u32x4 __attribute__((ext_vector_type(4)));
constexpr int BM = 256, BK = 64, HALF = 128, HTB = HALF * BK * 2  , STAGE_BYTES = 8 * HTB, NXCD = 8, WGM = 8;

__host__ __device__ __forceinline__ int lds_byte(int r, int c) { const int st = (r >> 4) * 2 + (c >> 5), rr = r & 15, cc = c & 31, ob = rr * 64 + cc * 2; return st * 1024 + (ob ^ (((ob >> 9) & 1) << 5)); }
__host__ __device__ __forceinline__ void stage_rc(int b, int& R, int& C) { const int st = b / 1024, sb = b % 1024, swz = sb ^ (((sb >> 9) & 1) << 5); R = (st >> 1) * 16 + swz / 64; C = (st & 1) * 32 + (swz % 64) / 2; }
__host__ __device__ __forceinline__ int perm32(int rho) { const int n = rho >> 4, i = rho & 15; return 8 * (i >> 2) + 4 * n + (i & 3); }

struct Unit { int pm, pn; };
struct Gemm { const bf16_t* A; const bf16_t* Bt; int M, N, K; };

struct StaticOrder {
    int nM, nN, nwg, G, c;
    __host__ __device__ void init(int M, int N, int G_, int c_) { nM = M / BM; nN = N / BM; nwg = nM * nN; G = G_; c = c_; }
    __host__ __device__ bool next(int i, Unit& u) const {
        const long L = (long)i * G + c; if (L >= nwg) return false;
        int wgid = (int)L; { const int q = nwg / NXCD, r = nwg % NXCD, xcd = wgid % NXCD, off = wgid / NXCD; wgid = (xcd < r ? xcd * (q + 1) : r * (q + 1) + (xcd - r) * q) + off; }
        const int nig = WGM * nN, gid = wgid / nig, fm = gid * WGM, gsz = (nM - fm) < WGM ? (nM - fm) : WGM;
        u.pm = fm + ((wgid % nig) % gsz); u.pn = (wgid % nig) / gsz; return true;
    }
    __device__ __forceinline__ void a_ready(const Unit&) const {}
    __device__ __forceinline__ void done(const Unit&) const {}
};

__device__ __forceinline__ unsigned cvt_pk_bf16(float lo, float hi) { unsigned r; asm volatile("v_cvt_pk_bf16_f32 %0, %1, %2" : "=v"(r) : "v"(lo), "v"(hi)); return r; }
typedef float f32x2 __attribute__((ext_vector_type(2)));
typedef float f32x2 __attribute__((ext_vector_type(2)));
template <class Epi, class Sched, bool ALIGN_EPI = false, bool SP2 = false>
__device__ __forceinline__ void gemm_phase(PG8_LAS unsigned char* lds, const Gemm g, const Sched& S, const Epi& E, const int wave_id) {
    int tid_; asm volatile("v_mbcnt_lo_u32_b32 %0, -1, 0\n\tv_mbcnt_hi_u32_b32 %0, -1, %0" : "=v"(tid_)); tid_ += wave_id * 64;
    const int tid = tid_, wid = __builtin_amdgcn_readfirstlane(tid >> 6), lane = tid & 63, wr = wid >> 2, wc = wid & 3, fr = lane & 15, fq = lane >> 4;
    const int K = g.K, nt = K / BK;
    unsigned voffA[2], voffB[2];
#pragma unroll
    for (int i = 0; i < 2; ++i) { int R, C; stage_rc(tid * 16 + i * 8192, R, C); const int Rb = Epi::PERM ? ((R & ~31) + perm32(R & 31)) : R;
        voffA[i] = (unsigned)(R * K + C) * 2u; voffB[i] = (unsigned)(Rb * K + C) * 2u; }
    const size_t kstep = (size_t)(BK * 2);
    const size_t hstep = (size_t)HALF * K * 2;
    const size_t tstep = 2 * hstep;
    const unsigned ldsw = (unsigned)wid * 1024u;
    const int aoff = lds_byte(wr * 64 + fr, fq * 8), boff = lds_byte(wc * 32 + fr, fq * 8);
#define PG8_SA(b, h) (((b) * 2 + (h)) * HTB)
#define PG8_SB(b, h) ((4 + (b) * 2 + (h)) * HTB)
#define PG8_STAGE(bufoff, gbase, voff) do { _Pragma("unroll") for (int _i = 0; _i < 2; ++_i) \
        __builtin_amdgcn_global_load_lds((const unsigned*)((const char*)(gbase) + (voff)[_i]), (PG8_LAS unsigned*)(lds + (bufoff) + ldsw + _i * 8192), 16, 0, 0); } while (0)
#define PG8_LDA(dst, b, h) do { _Pragma("unroll") for (int m = 0; m < 4; ++m) _Pragma("unroll") for (int k = 0; k < 2; ++k) dst[m][k] = *(const PG8_LAS bf16x8*)(lds + PG8_SA(b, h) + aoff + m * 2048 + k * 1024); } while (0)
#define PG8_LDB(dst, b, h) do { _Pragma("unroll") for (int n = 0; n < 2; ++n) _Pragma("unroll") for (int k = 0; k < 2; ++k) dst[n][k] = *(const PG8_LAS bf16x8*)(lds + PG8_SB(b, h) + boff + n * 2048 + k * 1024); } while (0)
#define PG8_MMA(ai, bj, At, Bt) do { __builtin_amdgcn_s_setprio(1); _Pragma("unroll") for (int m = 0; m < 4; ++m) _Pragma("unroll") for (int n = 0; n < 2; ++n) _Pragma("unroll") for (int k = 0; k < 2; ++k) \
        acc[ai][bj][m][n] = __builtin_amdgcn_mfma_f32_16x16x32_bf16(Bt[n][k], At[m][k], acc[ai][bj][m][n], 0, 0, 0); __builtin_amdgcn_s_setprio(0); } while (0)
#define PG8_WAIT_V(n) asm volatile("s_waitcnt vmcnt(" #n ")" ::: "memory")
#define PG8_WAIT_L(n) asm volatile("s_waitcnt lgkmcnt(" #n ")" ::: "memory")
#define PG8_BAR __builtin_amdgcn_s_barrier()
#define PG8_SCHED __builtin_amdgcn_sched_barrier(0)
    Unit cur, nxt; int ui = 0;
    if (!S.next(0, cur)) return;
    f32x4 acc[2][2][4][2];
#pragma unroll
    for (int a = 0; a < 2; ++a)
#pragma unroll
        for (int b = 0; b < 2; ++b)
#pragma unroll
            for (int m = 0; m < 4; ++m)
#pragma unroll
                for (int n = 0; n < 2; ++n) acc[a][b][m][n] = (f32x4){0.f, 0.f, 0.f, 0.f};
    bf16x8 At[4][2], B0[2][2], B1[2][2];
    const char* cA = (const char*)g.A + (size_t)cur.pm * tstep; const char* cB = (const char*)g.Bt + (size_t)cur.pn * tstep;
    S.a_ready(cur);
    if constexpr (SP2) {
        PG8_STAGE(PG8_SB(0, 0), cB, voffB); PG8_STAGE(PG8_SB(0, 1), cB + hstep, voffB); PG8_STAGE(PG8_SA(0, 0), cA, voffA); PG8_STAGE(PG8_SA(0, 1), cA + hstep, voffA);
        if (wr == 1) PG8_BAR;
        PG8_WAIT_V(2); PG8_BAR;
        PG8_STAGE(PG8_SB(1, 0), cB + kstep, voffB); PG8_STAGE(PG8_SA(1, 0), cA + kstep, voffA); PG8_STAGE(PG8_SB(1, 1), cB + hstep + kstep, voffB);
        PG8_WAIT_V(6); PG8_BAR;
    } else {
        PG8_STAGE(PG8_SB(0, 0), cB, voffB); PG8_STAGE(PG8_SA(0, 0), cA, voffA); PG8_STAGE(PG8_SB(0, 1), cB + hstep, voffB); PG8_STAGE(PG8_SA(0, 1), cA + hstep, voffA);
        if (wr == 1) PG8_BAR;
        PG8_WAIT_V(4); PG8_BAR;
        PG8_STAGE(PG8_SB(1, 0), cB + kstep, voffB); PG8_STAGE(PG8_SA(1, 0), cA + kstep, voffA); PG8_STAGE(PG8_SB(1, 1), cB + hstep + kstep, voffB);
        PG8_WAIT_V(6); PG8_BAR;
    }
    for (;;) {
        const bool has_next = S.next(ui + 1, nxt);
        const char* nA = has_next ? (const char*)g.A + (size_t)nxt.pm * tstep : cA; const char* nB = has_next ? (const char*)g.Bt + (size_t)nxt.pn * tstep : cB;
        for (int t = 0; t < nt; t += 2) {
            const bool last = (t == nt - 2);
            const char* a1 = cA + (size_t)(t + 1) * kstep;
            const char* a2 = last ? nA : cA + (size_t)(t + 2) * kstep; const char* b2 = last ? nB : cB + (size_t)(t + 2) * kstep;
            const char* a3 = a2 + kstep; const char* b3 = b2 + kstep;
            if (last && has_next) S.a_ready(nxt);
            if constexpr (SP2) {
            PG8_LDB(B0, 0, 0); PG8_LDB(B1, 0, 1); PG8_SCHED; PG8_LDA(At, 0, 0); PG8_STAGE(PG8_SA(1, 1), a1 + hstep, voffA);
            PG8_WAIT_V(8); PG8_WAIT_L(0); PG8_BAR; PG8_MMA(0, 0, At, B0); PG8_MMA(0, 1, At, B1); PG8_BAR; PG8_SCHED;
            PG8_LDA(At, 0, 1); PG8_STAGE(PG8_SB(0, 0), b2, voffB); PG8_STAGE(PG8_SB(0, 1), b2 + hstep, voffB); PG8_STAGE(PG8_SA(0, 0), a2, voffA);
            PG8_WAIT_V(8); PG8_WAIT_L(0); PG8_BAR; PG8_MMA(1, 0, At, B0); PG8_MMA(1, 1, At, B1); PG8_BAR; PG8_SCHED;
            PG8_LDB(B0, 1, 0); PG8_LDB(B1, 1, 1); PG8_SCHED; PG8_LDA(At, 1, 0); PG8_STAGE(PG8_SA(0, 1), a2 + hstep, voffA);
            PG8_WAIT_V(8); PG8_WAIT_L(0); PG8_BAR; PG8_MMA(0, 0, At, B0); PG8_MMA(0, 1, At, B1); PG8_BAR; PG8_SCHED;
            PG8_LDA(At, 1, 1); PG8_STAGE(PG8_SB(1, 0), b3, voffB); PG8_STAGE(PG8_SB(1, 1), b3 + hstep, voffB); PG8_STAGE(PG8_SA(1, 0), a3, voffA);
            PG8_WAIT_V(8); PG8_WAIT_L(0); PG8_BAR; PG8_MMA(1, 0, At, B0); PG8_MMA(1, 1, At, B1); PG8_BAR; PG8_SCHED;
            } else {
            PG8_LDB(B0, 0, 0); PG8_SCHED; PG8_LDA(At, 0, 0); PG8_STAGE(PG8_SA(1, 1), a1 + hstep, voffA);
            PG8_WAIT_L(8); PG8_BAR; PG8_WAIT_L(0); PG8_MMA(0, 0, At, B0); PG8_BAR; PG8_SCHED;
            PG8_LDB(B1, 0, 1); PG8_STAGE(PG8_SB(0, 0), b2, voffB);
            PG8_BAR; PG8_WAIT_L(0); PG8_MMA(0, 1, At, B1); PG8_BAR;
            PG8_LDA(At, 0, 1); PG8_STAGE(PG8_SA(0, 0), a2, voffA);
            PG8_BAR; PG8_WAIT_L(0); PG8_MMA(1, 0, At, B0); PG8_BAR; PG8_SCHED;
            PG8_STAGE(PG8_SB(0, 1), b2 + hstep, voffB);
            PG8_WAIT_V(6); PG8_BAR; PG8_MMA(1, 1, At, B1); PG8_BAR;
            PG8_LDB(B0, 1, 0); PG8_SCHED; PG8_LDA(At, 1, 0); PG8_STAGE(PG8_SA(0, 1), a2 + hstep, voffA);
            PG8_WAIT_L(8); PG8_BAR; PG8_WAIT_L(0); PG8_MMA(0, 0, At, B0); PG8_BAR; PG8_SCHED;
            PG8_LDB(B1, 1, 1); PG8_STAGE(PG8_SB(1, 0), b3, voffB);
            PG8_BAR; PG8_WAIT_L(0); PG8_MMA(0, 1, At, B1); PG8_BAR;
            PG8_LDA(At, 1, 1); PG8_STAGE(PG8_SA(1, 0), a3, voffA);
            PG8_BAR; PG8_WAIT_L(0); PG8_MMA(1, 0, At, B0); PG8_BAR; PG8_SCHED;
            PG8_STAGE(PG8_SB(1, 1), b3 + hstep, voffB);
            PG8_WAIT_V(6); PG8_BAR; PG8_MMA(1, 1, At, B1); PG8_BAR;
            }
        }
        if constexpr (ALIGN_EPI) { if (wr == 0) PG8_BAR; }
        if constexpr (!Epi::AFTER_DRAIN) { E(acc, cur, wr, wc, fr, fq); S.done(cur); }
        if (!has_next) break;
#pragma unroll
        for (int a = 0; a < 2; ++a)
#pragma unroll
            for (int b = 0; b < 2; ++b)
#pragma unroll
                for (int m = 0; m < 4; ++m)
#pragma unroll
                    for (int n = 0; n < 2; ++n) acc[a][b][m][n] = (f32x4){0.f, 0.f, 0.f, 0.f};
        cur = nxt; cA = nA; cB = nB; ++ui;
        if constexpr (ALIGN_EPI) { if (wr == 1) PG8_BAR; }
    }
    PG8_WAIT_V(0);
    if constexpr (!ALIGN_EPI) { if (wr == 0) PG8_BAR; }
    PG8_BAR;
    if constexpr (Epi::AFTER_DRAIN) { E.fused(acc, cur, wr, wc, fr, fq, lds, wid, lane); S.done(cur); }
#undef PG8_SA
#undef PG8_SB
#undef PG8_STAGE
#undef PG8_LDA
#undef PG8_LDB
#undef PG8_MMA
#undef PG8_WAIT_V
#undef PG8_WAIT_L
#undef PG8_BAR
#undef PG8_SCHED
}
}

constexpr int NWAVES = 8;
constexpr int DM = 2048, SEQ = 16384, NBATCH = 2, NTOK = NBATCH * SEQ;
constexpr int DCA = 1024, DINP = 5120, NEXP = 64, DEXP = 1024, LISTCAP = 32768, NMODC = 6 * DM;
constexpr int PW = 3072;
constexpr float EPS = 1e-6f;

constexpr size_t MiB = 1u << 20;
constexpr size_t WS_CTL = 0, CTL_ZERO_BYTES = 65536;
constexpr size_t WS_MOD = 1 * MiB;
constexpr size_t WS_WIN = 2 * MiB;
constexpr size_t WS_WOUT = 22 * MiB;
constexpr size_t WS_LISTA = 30 * MiB;
constexpr size_t WS_LISTW = 38 * MiB;
constexpr size_t WS_WR = 46 * MiB;
constexpr size_t WS_WGU = 64 * MiB;
constexpr size_t WS_WD = 576 * MiB;
constexpr size_t WS_H = 832 * MiB;
constexpr size_t WS_P = 960 * MiB;
constexpr size_t WS_Y = 1152 * MiB;
constexpr size_t WS_O = 1280 * MiB;
constexpr size_t WS_X1 = 1410 * MiB;
constexpr size_t WS_END = 1538 * MiB;
constexpr int CW_TMO = 0, CW_Q = 64, CW_DONE = 128, CW_BAR = 4096, CW_CNT = 8192;

constexpr int RING_OFF = 0, RING_BYTES = 131072;
constexpr int LDSCTL_OFF = 143360;
constexpr int TAB_OFF = LDSCTL_OFF + 1024;
constexpr int LDS_BYTES = 147456;

#define GAS __attribute__((address_space(1)))
#define LAS __attribute__((address_space(3)))
typedef unsigned short bf16;
typedef unsigned v4u __attribute__((ext_vector_type(4)));
typedef unsigned v2u __attribute__((ext_vector_type(2)));
using pg8::f32x4; using pg8::f32x2; using pg8::bf16x8;
typedef GAS unsigned gu32;
#define RLX_AGENT __ATOMIC_RELAXED, __HIP_MEMORY_SCOPE_AGENT
#define LDS_WAIT() asm volatile("s_waitcnt lgkmcnt(0)" ::: "memory")
__device__ __forceinline__ unsigned f2bf(float f) { unsigned u = __builtin_bit_cast(unsigned, f); return (u + 0x7fffu + ((u >> 16) & 1u)) >> 16; }
__device__ __forceinline__ unsigned pk2(float lo, float hi) { return f2bf(lo) | (f2bf(hi) << 16); }
__device__ __forceinline__ float bf_lo(unsigned u) { return __builtin_bit_cast(float, u << 16); }
__device__ __forceinline__ float bf_hi(unsigned u) { return __builtin_bit_cast(float, u & 0xffff0000u); }
__device__ __forceinline__ float wave_sum(float v) {
#pragma unroll
    for (int o = 1; o < 64; o <<= 1) v += __shfl_xor(v, o);
    return v;
}
constexpr float SC_H = 16.0f, SC_WGU = 64.0f, SC_HID = 8.0f, SC_WD = 32.0f;
__device__ __forceinline__ unsigned pk4_fp8(float a, float b, float c, float d) {
    a = __builtin_fminf(__builtin_fmaxf(a, -448.0f), 448.0f); b = __builtin_fminf(__builtin_fmaxf(b, -448.0f), 448.0f);
    c = __builtin_fminf(__builtin_fmaxf(c, -448.0f), 448.0f); d = __builtin_fminf(__builtin_fmaxf(d, -448.0f), 448.0f);
    int w = __builtin_amdgcn_cvt_pk_fp8_f32(a, b, 0, false); w = __builtin_amdgcn_cvt_pk_fp8_f32(c, d, w, true); return (unsigned)w; }
#define DPP_STEP(v, ctrl) ((v) + __builtin_bit_cast(float, __builtin_amdgcn_update_dpp(0, __builtin_bit_cast(int, (v)), (ctrl), 0xF, 0xF, true)))
__device__ __forceinline__ float wave_sum_dpp(float v) {
    v = DPP_STEP(v, 0xB1);
    v = DPP_STEP(v, 0x4E);
    v = DPP_STEP(v, 0x141);
    v = DPP_STEP(v, 0x140);
    const int iv = __builtin_bit_cast(int, v);
    const float r0 = __builtin_bit_cast(float, __builtin_amdgcn_readlane(iv, 0)), r1 = __builtin_bit_cast(float, __builtin_amdgcn_readlane(iv, 16));
    const float r2 = __builtin_bit_cast(float, __builtin_amdgcn_readlane(iv, 32)), r3 = __builtin_bit_cast(float, __builtin_amdgcn_readlane(iv, 48));
    return (r0 + r1) + (r2 + r3);
}
__device__ __forceinline__ void wave_sum3_dpp(float& a, float& b, float& c) {
    a = DPP_STEP(a, 0xB1); b = DPP_STEP(b, 0xB1); c = DPP_STEP(c, 0xB1);
    a = DPP_STEP(a, 0x4E); b = DPP_STEP(b, 0x4E); c = DPP_STEP(c, 0x4E);
    a = DPP_STEP(a, 0x141); b = DPP_STEP(b, 0x141); c = DPP_STEP(c, 0x141);
    a = DPP_STEP(a, 0x140); b = DPP_STEP(b, 0x140); c = DPP_STEP(c, 0x140);
    const int ia = __builtin_bit_cast(int, a), ib = __builtin_bit_cast(int, b), ic = __builtin_bit_cast(int, c);
#define RL_(v, l) __builtin_bit_cast(float, __builtin_amdgcn_readlane((v), (l)))
    a = (RL_(ia, 0) + RL_(ia, 16)) + (RL_(ia, 32) + RL_(ia, 48));
    b = (RL_(ib, 0) + RL_(ib, 16)) + (RL_(ib, 32) + RL_(ib, 48));
    c = (RL_(ic, 0) + RL_(ic, 16)) + (RL_(ic, 32) + RL_(ic, 48));
#undef RL_
}
typedef _Float16 f16x2_ __attribute__((ext_vector_type(2)));
typedef _Float16 f16x8_ __attribute__((ext_vector_type(8)));
__device__ __forceinline__ unsigned pkh2(float lo, float hi) { const f16x2_ h = {(_Float16)lo, (_Float16)hi}; return __builtin_bit_cast(unsigned, h); }
__device__ __forceinline__ float h_lo(unsigned u) { return (float)__builtin_bit_cast(f16x2_, u).x; }
__device__ __forceinline__ float h_hi(unsigned u) { return (float)__builtin_bit_cast(f16x2_, u).y; }
__device__ __forceinline__ unsigned cvt2bf(float lo, float hi) { unsigned r; asm volatile("v_cvt_pk_bf16_f32 %0, %1, %2" : "=v"(r) : "v"(lo), "v"(hi)); return r; }
__device__ __forceinline__ float dot4(f32x4 a, f32x4 b) { return (a.x * b.x + a.y * b.y) + (a.z * b.z + a.w * b.w); }

__device__ __forceinline__ int lane_id_fresh() { int l; asm volatile("v_mbcnt_lo_u32_b32 %0, -1, 0\n\tv_mbcnt_hi_u32_b32 %0, -1, %0" : "=v"(l)); return l; }
#define XB_TMO      128
#define XB_XCNT(j)  (256  + 64 * (j))
#define XB_XSUB(j)  (1280 + 64 * (j))
#define XB_XGEN(j)  (2304 + 64 * (j))
#define XB_TOP      3328
#define XB_TOPGEN   3392
#define XCD_BAR_WORDS 3456
#define XB_SPIN_CAP (1u << 22)

__device__ __forceinline__ unsigned xb_ld(unsigned* p)              { return __hip_atomic_load(p, __ATOMIC_RELAXED, __HIP_MEMORY_SCOPE_AGENT); }
__device__ __forceinline__ unsigned xb_add(unsigned* p, unsigned v) { return __hip_atomic_fetch_add(p, v, __ATOMIC_RELAXED, __HIP_MEMORY_SCOPE_AGENT); }
__device__ __forceinline__ unsigned xb_xcc_id() { return (unsigned)__builtin_amdgcn_s_getreg((3 << 11) | 20) & 0xFu; }
#define XB_SPIN(cond, bar) do { unsigned _sp = 0; while (cond) { __builtin_amdgcn_s_sleep(1); \
    if ((++_sp & 255u) == 0u) { if (xb_ld(&(bar)[XB_TMO])) break; if (_sp > XB_SPIN_CAP) { atomicAdd(&(bar)[XB_TMO], 1u); break; } } } } while (0)

struct XcdBarrier { unsigned* bar; unsigned x; volatile LAS unsigned* st; };

__device__ __forceinline__ XcdBarrier xcd_barrier_post(unsigned* bar, volatile LAS unsigned* st) {
    XcdBarrier b; b.bar = bar; b.x = xb_xcc_id(); b.st = st;
    if (threadIdx.x == 0) (void)xb_add(&bar[XB_XCNT(b.x)], 1u);
    return b;
}
__device__ __forceinline__ void xcd_barrier_complete(unsigned* bar, unsigned x, unsigned& nloc, unsigned& nx) {
    const unsigned G = gridDim.x * gridDim.y * gridDim.z;
    unsigned sum, cnt, mine, sp = 0u;
    for (;;) {
        sum = 0u; cnt = 0u; mine = 0u;
#pragma unroll
        for (unsigned j = 0; j < 16; ++j) { const unsigned c = xb_ld(&bar[XB_XCNT(j)]); sum += c; cnt += (c > 0u) ? 1u : 0u; mine = (j == x) ? c : mine; }
        if (sum == G) break;
        __builtin_amdgcn_s_sleep(1);
        if ((++sp & 255u) == 0u) { if (xb_ld(&bar[XB_TMO])) break; if (sp > XB_SPIN_CAP) { atomicAdd(&bar[XB_TMO], 1u); break; } }
    }
    nloc = mine > 0u ? mine : 1u; nx = cnt > 0u ? cnt : 1u;
}
__device__ __forceinline__ void xcd_barrier(const XcdBarrier& b, const int wave_id) {
    asm volatile("s_waitcnt vmcnt(0)" ::: "memory");
    __syncthreads();
    if (wave_id == 0 && lane_id_fresh() == 0) {
        unsigned* bar = b.bar; asm volatile("" : "+s"(bar));
        __builtin_amdgcn_s_waitcnt(0);
        unsigned nloc = b.st[0], nx = b.st[1];
        if (nloc == 0u) { xcd_barrier_complete(bar, b.x, nloc, nx); b.st[0] = nloc; b.st[1] = nx; }
        const unsigned old = xb_add(&bar[XB_XSUB(b.x)], 1u);
        const unsigned gen = old / nloc;
        if (old + 1u == (gen + 1u) * nloc) {
            __builtin_amdgcn_fence(__ATOMIC_RELEASE, "agent");
            asm volatile("s_waitcnt vmcnt(0)" ::: "memory");
            const unsigned og = xb_add(&bar[XB_TOP], 1u);
            const unsigned tg = og / nx;
            if (og + 1u == (tg + 1u) * nx) xb_add(&bar[XB_TOPGEN], 1u);
            else XB_SPIN(xb_ld(&bar[XB_TOPGEN]) == tg, bar);
            __builtin_amdgcn_fence(__ATOMIC_ACQUIRE, "agent");
            xb_add(&bar[XB_XGEN(b.x)], 1u);
            asm volatile("s_waitcnt vmcnt(0)" ::: "memory");
        } else {
            XB_SPIN(xb_ld(&bar[XB_XGEN(b.x)]) == gen, bar);
            __builtin_amdgcn_fence(__ATOMIC_ACQUIRE, "agent");
            asm volatile("s_waitcnt vmcnt(0)" ::: "memory");
        }
    }
    __syncthreads();
}

struct Args {
    const float* in[23]; float* out_; unsigned char* ws;
#define ARGS_IN(name, k) __device__ __forceinline__ const float* name() const { return in[k]; }
    ARGS_IN(x, 0) ARGS_IN(c, 1) ARGS_IN(w_ada, 2) ARGS_IN(b_ada, 3) ARGS_IN(g_pre1, 4) ARGS_IN(g_post1, 5) ARGS_IN(w_in, 6) ARGS_IN(conv_a, 7) ARGS_IN(norm_a, 8)
    ARGS_IN(conv_b, 9) ARGS_IN(conv_b_bias, 10) ARGS_IN(ln_g, 11) ARGS_IN(ln_b, 12) ARGS_IN(w_out, 13) ARGS_IN(g_pre2, 14) ARGS_IN(g_post2, 15) ARGS_IN(w_rg, 16)
    ARGS_IN(b_rg, 17) ARGS_IN(w_re, 18) ARGS_IN(b_re, 19) ARGS_IN(w_eg, 20) ARGS_IN(w_eu, 21) ARGS_IN(w_ed, 22)
#undef ARGS_IN
    __device__ __forceinline__ float* out() const { return out_; }
    __device__ __forceinline__ unsigned* ctl() const { return (unsigned*)(ws + WS_CTL); }
    __device__ __forceinline__ float* mod() const { return (float*)(ws + WS_MOD); }
    __device__ __forceinline__ bf16* WIN() const { return (bf16*)(ws + WS_WIN); }
    __device__ __forceinline__ bf16* WOUT() const { return (bf16*)(ws + WS_WOUT); }
    __device__ __forceinline__ unsigned char* WGU() const { return ws + WS_WGU; }
    __device__ __forceinline__ unsigned char* WD() const { return ws + WS_WD; }
    __device__ __forceinline__ bf16* H() const { return (bf16*)(ws + WS_H); }
    __device__ __forceinline__ bf16* P() const { return (bf16*)(ws + WS_P); }
    __device__ __forceinline__ bf16* Y() const { return (bf16*)(ws + WS_Y); }
    __device__ __forceinline__ bf16* O() const { return (bf16*)(ws + WS_O); }
    __device__ __forceinline__ unsigned char* HID() const { return ws + WS_P; }
    __device__ __forceinline__ unsigned char* H8() const { return ws + WS_H; }
    __device__ __forceinline__ bf16* YD() const { return (bf16*)(ws + WS_Y); }
    __device__ __forceinline__ int* lista() const { return (int*)(ws + WS_LISTA); }
    __device__ __forceinline__ float* listw() const { return (float*)(ws + WS_LISTW); }
    __device__ __forceinline__ bf16* WR() const { return (bf16*)(ws + WS_WR); }
    __device__ __forceinline__ bf16* X1() const { return (bf16*)(ws + WS_X1); }
};
struct Frame { LAS unsigned char* lds; int tid, lane, wave, vcu, G; };
__device__ __forceinline__ Frame phase_frame(const Frame& F0) { Frame F = F0; const int l = lane_id_fresh(); F.lane = l; F.tid = F0.wave * 64 + l; return F; }

__device__ __forceinline__ void p0_ada(const Frame& F, const Args& A) {
    if ((int)blockIdx.x >= 192) return;
    LAS float* sc = (LAS float*)(F.lds + RING_OFF);
    LAS float* red = (LAS float*)(F.lds + RING_OFF + 16384);
    for (int i = F.tid; i < 2 * DM; i += NWAVES * 64) { const int b = i >> 11, k = i & (DM - 1); const float cv = A.c()[b * DM + k]; sc[k * 2 + b] = cv / (1.0f + expf(-cv)); }
    __syncthreads();
    for (int it = blockIdx.x; it < 192; it += F.G) {
        const int k0 = F.wave * 256;
        const float* wp = A.w_ada() + (size_t)k0 * NMODC + it * 64 + F.lane;
        float a0 = 0.f, a1 = 0.f;
        for (int kk = 0; kk < 256; kk += 64) {
            float wv[64];
#pragma unroll
            for (int k = 0; k < 64; ++k) wv[k] = wp[(size_t)(kk + k) * NMODC];
#pragma unroll
            for (int k = 0; k < 64; ++k) { const f32x2 s = *(const LAS f32x2*)(sc + (k0 + kk + k) * 2); a0 += s.x * wv[k]; a1 += s.y * wv[k]; }
        }
        red[(F.wave * 2 + 0) * 64 + F.lane] = a0; red[(F.wave * 2 + 1) * 64 + F.lane] = a1;
        __syncthreads();
        if (F.tid < 128) { const int b = F.tid >> 6, l = F.tid & 63; float s = 0.f;
#pragma unroll
            for (int w = 0; w < 8; ++w) s += red[(w * 2 + b) * 64 + l];
            A.mod()[b * NMODC + it * 64 + l] = s + A.b_ada()[it * 64 + l]; }
        __syncthreads();
    }
}
__host__ __device__ __forceinline__ int inproj_row(int n0) {
    if (n0 < 1024) return n0;
    const int seg = (n0 - 1024) >> 10, off = (n0 - 1024) & 1023, j = off >> 7, r = off & 127;
    return (seg < 2 ? 1024 : 3072) + 256 * j + 128 * (seg & 1) + r;
}
__device__ __forceinline__ void transpose_item_bf16(const float* W, int N, int k0, int n0, bf16* dst, int ldk, LAS float* scr, int lane) {
    float tv[32];
    { const float* wp = W + (size_t)(k0 + (lane >> 5)) * N + n0 + (lane & 31);
#pragma unroll
      for (int i = 0; i < 32; ++i) tv[i] = wp[(size_t)(2 * i) * N]; }
#pragma unroll
    for (int i = 0; i < 32; ++i) scr[(2 * i + (lane >> 5)) * 33 + (lane & 31)] = tv[i];
    LDS_WAIT(); asm volatile("" ::: "memory");
    const int c = lane & 7;
#pragma unroll
    for (int j = 0; j < 4; ++j) { const int n = (lane >> 3) + 8 * j; const LAS float* sp = scr + (8 * c) * 33 + n;
        v4u o; o.x = pk2(sp[0 * 33], sp[1 * 33]); o.y = pk2(sp[2 * 33], sp[3 * 33]); o.z = pk2(sp[4 * 33], sp[5 * 33]); o.w = pk2(sp[6 * 33], sp[7 * 33]);
        *(v4u*)(dst + (size_t)n * ldk + 8 * c) = o; }
    LDS_WAIT(); asm volatile("" ::: "memory");
}
__device__ __forceinline__ void p0_router_weights(const Frame& F, const Args& A) {
    const int gt = F.vcu * NWAVES * 64 + F.tid, NGT = F.G * NWAVES * 64;
    for (int it = gt; it < 8 * 8 * 5 * 64; it += NGT) {
        const int l = it & 63, nf = (it >> 6) % 5, wc = it / 320, c = wc & 7, w = wc >> 3;
        const int n = 16 * nf + (l & 15), kg = l >> 4;
        float v[8];
#pragma unroll
        for (int j = 0; j < 8; ++j) { const int k = 256 * w + 64 * (c >> 1) + 16 * kg + 8 * (c & 1) + j;
            v[j] = n < 8 ? A.w_rg()[k * 8 + n] : (n < 72 ? A.w_re()[((size_t)((n - 8) >> 3) * DM + k) * 8 + ((n - 8) & 7)] : 0.f); }
        v4u* dst = (v4u*)A.WR() + (size_t)((w * 8 + c) * 5 + nf) * 64 + l;
        dst[0] = (v4u){pkh2(v[0], v[1]), pkh2(v[2], v[3]), pkh2(v[4], v[5]), pkh2(v[6], v[7])};
    }
}
constexpr int P0X_ITEMS = 3 * NEXP * 64;
struct XItem { const float* src; unsigned char* dst; int N; float scale; };
__device__ __forceinline__ XItem p0x_item(const Args& A, int it, int w) {
    XItem t; const int mat = it / (NEXP * 64), r = it - mat * (NEXP * 64), e = r >> 6, rr = r & 63;
    if (mat < 2) { const int kt = rr >> 2, nb = rr & 3; t.N = DEXP; t.scale = SC_WGU;
        t.src = (mat ? A.w_eu() : A.w_eg()) + (size_t)e * DM * DEXP + (size_t)(128 * kt) * DEXP + 256 * nb;
        const int nn = 32 * w, drow = 256 * (2 * nb + (nn >> 7)) + 128 * mat + (nn & 127);
        t.dst = A.WGU() + ((size_t)(e * 16 + kt) * 2048 + drow) * 128; }
    else { const int kt = rr >> 3, nb = rr & 7; t.N = DM; t.scale = SC_WD;
        t.src = A.w_ed() + (size_t)e * DEXP * DM + (size_t)(128 * kt) * DM + 256 * nb;
        t.dst = A.WD() + ((size_t)(e * 8 + kt) * 2048 + 256 * nb + 32 * w) * 128; }
    return t;
}
__device__ __forceinline__ void p0x_load(const XItem& t, int w, int lane, f32x4 (&v)[16]) {
    const f32x4* p = (const f32x4*)(t.src + (size_t)(16 * w) * t.N) + lane;
#pragma unroll
    for (int j = 0; j < 16; ++j) v[j] = __builtin_nontemporal_load((const f32x4*)((const float*)p + (size_t)j * t.N));
}
#define XW_BAR() do { LDS_WAIT(); __builtin_amdgcn_s_barrier(); asm volatile("" ::: "memory"); } while (0)
__device__ __forceinline__ void xw_put(LAS float* tile, int w, int lane, const f32x4 (&v)[16]) {
#pragma unroll
    for (int j = 0; j < 16; ++j) *(LAS f32x4*)(tile + (16 * w + j) * 260 + 4 * lane) = v[j];
}
__device__ __forceinline__ void xw_emit(const LAS float* tile, const XItem& cur, int w, int lane) {
    const int n = lane & 31, kh = lane >> 5; const float sc = cur.scale;
    const LAS float* col = tile + 32 * w + n;
#pragma unroll
    for (int q = 0; q < 4; ++q) { const LAS float* sp = col + (32 * q + 16 * kh) * 260;
        v4u o;
        o.x = pk4_fp8(sp[0 * 260] * sc, sp[1 * 260] * sc, sp[2 * 260] * sc, sp[3 * 260] * sc);     o.y = pk4_fp8(sp[4 * 260] * sc, sp[5 * 260] * sc, sp[6 * 260] * sc, sp[7 * 260] * sc);
        o.z = pk4_fp8(sp[8 * 260] * sc, sp[9 * 260] * sc, sp[10 * 260] * sc, sp[11 * 260] * sc);   o.w = pk4_fp8(sp[12 * 260] * sc, sp[13 * 260] * sc, sp[14 * 260] * sc, sp[15 * 260] * sc);
        *(v4u*)(cur.dst + (size_t)n * 128 + 32 * q + 16 * kh) = o; }
}
__device__ __forceinline__ void xw_put8(LAS unsigned* tile, int w, int lane, const f32x4 (&v)[16], float sc) {
#pragma unroll
    for (int j = 0; j < 16; ++j) tile[(16 * w + j) * 65 + lane] = pk4_fp8(v[j].x * sc, v[j].y * sc, v[j].z * sc, v[j].w * sc);
}
__device__ __forceinline__ void xw_emit8(const LAS unsigned* tile, unsigned char* dst, int w, int lane) {
    const int g = lane & 7, kc = lane >> 3;
    const LAS unsigned* col = tile + (16 * kc) * 65 + 8 * w + g;
    unsigned o[4][4];
#pragma unroll
    for (int b4 = 0; b4 < 4; ++b4) { const unsigned d0 = col[(4 * b4 + 0) * 65], d1 = col[(4 * b4 + 1) * 65], d2 = col[(4 * b4 + 2) * 65], d3 = col[(4 * b4 + 3) * 65];
        const unsigned t01l = __builtin_amdgcn_perm(d1, d0, 0x05010400u), t01h = __builtin_amdgcn_perm(d1, d0, 0x07030602u);
        const unsigned t23l = __builtin_amdgcn_perm(d3, d2, 0x05010400u), t23h = __builtin_amdgcn_perm(d3, d2, 0x07030602u);
        o[0][b4] = __builtin_amdgcn_perm(t23l, t01l, 0x05040100u); o[1][b4] = __builtin_amdgcn_perm(t23l, t01l, 0x07060302u);
        o[2][b4] = __builtin_amdgcn_perm(t23h, t01h, 0x05040100u); o[3][b4] = __builtin_amdgcn_perm(t23h, t01h, 0x07060302u); }
#pragma unroll
    for (int j = 0; j < 4; ++j) *(v4u*)(dst + (size_t)(4 * g + j) * 128 + 16 * kc) = (v4u){o[j][0], o[j][1], o[j][2], o[j][3]};
}
template <class T> __device__ __forceinline__ T* uniform_ptr(T* p) {
    const unsigned long long v = (unsigned long long)p; const unsigned lo = (unsigned)__builtin_amdgcn_readfirstlane((int)(unsigned)v), hi = (unsigned)__builtin_amdgcn_readfirstlane((int)(unsigned)(v >> 32));
    return (T*)(((unsigned long long)hi << 32) | lo);
}
__device__ __forceinline__ void xq_issue(const unsigned* ctl, unsigned& cl, unsigned& sv) {
    asm volatile("s_nop 4\n\tglobal_atomic_add %0, %2, %3, %4 offset:256 sc0\n\tglobal_load_dword %1, %2, %4 offset:512 sc1" : "=&v"(cl), "=&v"(sv) : "v"(0u), "v"(1u), "s"(ctl) : "memory");
}
static_assert(CW_Q * 4 == 256 && CW_DONE * 4 == 512, "xq_issue hard-codes the byte offsets of the queue and stop words");
__device__ __forceinline__ void expert_worker(const Frame& F, const Args& A, const unsigned stop_target) {
    LAS unsigned* tile0 = (LAS unsigned*)(F.lds + RING_OFF); LAS unsigned* tile1 = tile0 + 128 * 65; LAS unsigned* tile2 = tile1 + 128 * 65;
    volatile LAS int* qs = (volatile LAS int*)(F.lds + LDSCTL_OFF + 64);
    const int w = F.wave, lane = F.lane;
    const unsigned* ctl = uniform_ptr(A.ctl());
    if (F.tid == 0) {
        const bool stop = stop_target != 0u && __hip_atomic_load(ctl + CW_DONE, RLX_AGENT) >= stop_target;
        const int base = stop ? P0X_ITEMS : (int)__hip_atomic_fetch_add(A.ctl() + CW_Q, 4u, RLX_AGENT);
        qs[0] = base; qs[1] = base + 1; qs[2] = base + 2; qs[3] = base + 3; }
    __syncthreads();
    int i0 = qs[0], i1 = qs[1], i2 = qs[2], i3 = qs[3];
    if (i0 >= P0X_ITEMS) return;
    unsigned cl = 0u, sv = 0u; bool pend = (F.wave == 0) && i3 < P0X_ITEMS, stopped = false;
    if (pend && lane == 0) xq_issue(ctl, cl, sv);
    XItem c0 = p0x_item(A, i0, w), c1 = p0x_item(A, i1 < P0X_ITEMS ? i1 : i0, w), c2 = p0x_item(A, i2 < P0X_ITEMS ? i2 : i0, w); f32x4 va[16], vb[16], vc[16];
    p0x_load(c0, w, lane, va); p0x_load(c1, w, lane, vb); p0x_load(c2, w, lane, vc);
#define XW_CLAIM(slot) do { if (F.wave == 0) { int _n = P0X_ITEMS; \
        if (pend) { asm volatile("s_waitcnt vmcnt(16)" ::: "memory"); asm volatile("" : "+v"(cl), "+v"(sv)); _n = __builtin_amdgcn_readfirstlane((int)cl); \
            if (stop_target != 0u && (unsigned)__builtin_amdgcn_readfirstlane((int)sv) >= stop_target) stopped = true; } \
        if (lane == 0) qs[slot] = _n; \
        pend = !stopped && _n < P0X_ITEMS; \
        if (pend && lane == 0) xq_issue(ctl, cl, sv); } } while (0)
    for (;;) {
        xw_put8(tile0, w, lane, va, c0.scale);
        XW_CLAIM(0);
        XW_BAR();
        const XItem cA = p0x_item(A, i3 < P0X_ITEMS ? i3 : i0, w);
        p0x_load(cA, w, lane, va);
        xw_emit8(tile0, c0.dst, w, lane);
        if (i1 >= P0X_ITEMS) break;
        const int n0 = qs[0];
        xw_put8(tile1, w, lane, vb, c1.scale);
        XW_CLAIM(1);
        XW_BAR();
        const XItem cB = p0x_item(A, n0 < P0X_ITEMS ? n0 : i1, w);
        p0x_load(cB, w, lane, vb);
        xw_emit8(tile1, c1.dst, w, lane);
        if (i2 >= P0X_ITEMS) break;
        const int n1 = qs[1];
        xw_put8(tile2, w, lane, vc, c2.scale);
        XW_CLAIM(2);
        XW_BAR();
        const XItem cC = p0x_item(A, n1 < P0X_ITEMS ? n1 : i2, w);
        p0x_load(cC, w, lane, vc);
        xw_emit8(tile2, c2.dst, w, lane);
        if (i3 >= P0X_ITEMS) break;
        i0 = i3; c0 = cA; i1 = n0; c1 = cB; i2 = n1; c2 = cC; i3 = qs[2];
    }
    XW_BAR();
#undef XW_CLAIM
}
__device__ __forceinline__ void p0_weights(const Frame& F, const Args& A) {
    LAS float* scr = (LAS float*)(F.lds + RING_OFF + F.wave * 16896);
    const int gw = F.vcu * NWAVES + F.wave, NGW = F.G * NWAVES;
    constexpr int I_IN = 32 * 160, I_OUT = 32 * 64;
    for (int it = gw; it < I_IN + I_OUT; it += NGW) {
        if (it < I_IN) { const int kb = it / 160, nb = it % 160, n0 = 32 * nb; transpose_item_bf16(A.w_in(), DINP, 64 * kb, n0, A.WIN() + (size_t)inproj_row(n0) * DM + 64 * kb, DM, scr, F.lane); }
        else { const int r = it - I_IN, kb = r / 64, nb = r % 64, n0 = 32 * nb; transpose_item_bf16(A.w_out(), DM, 64 * kb, n0, A.WOUT() + (size_t)n0 * DM + 64 * kb, DM, scr, F.lane); }
    }
}

__device__ __forceinline__ void p1_norm1(const Frame& F, const Args& A) {
    const int gw = F.vcu * NWAVES + F.wave, NGW = F.G * NWAVES;
    f32x4 a1[8], sh[8]; int bcur = -1;
    for (int m0 = gw; m0 < NTOK; m0 += 2 * NGW) {
        const int m1 = m0 + NGW; const bool has1 = (m1 < NTOK) && ((m1 >> 14) == (m0 >> 14));
        const f32x4* xr0 = (const f32x4*)(A.x() + (size_t)m0 * DM) + 2 * F.lane;
        const f32x4* xr1 = (const f32x4*)(A.x() + (size_t)(has1 ? m1 : m0) * DM) + 2 * F.lane;
        f32x4 v0[8], v1[8];
#pragma unroll
        for (int j = 0; j < 4; ++j) { v0[2 * j] = xr0[128 * j]; v0[2 * j + 1] = xr0[128 * j + 1]; v1[2 * j] = xr1[128 * j]; v1[2 * j + 1] = xr1[128 * j + 1]; }
        if ((m0 >> 14) != bcur) { bcur = m0 >> 14;
            const f32x4* g = (const f32x4*)A.g_pre1() + 2 * F.lane; const f32x4* shp = (const f32x4*)(A.mod() + bcur * NMODC) + 2 * F.lane; const f32x4* scp = (const f32x4*)(A.mod() + bcur * NMODC + DM) + 2 * F.lane;
#pragma unroll
            for (int j = 0; j < 4; ++j) { a1[2 * j] = g[128 * j] * (scp[128 * j] + 1.0f); a1[2 * j + 1] = g[128 * j + 1] * (scp[128 * j + 1] + 1.0f); sh[2 * j] = shp[128 * j]; sh[2 * j + 1] = shp[128 * j + 1]; } }
        float s0 = 0.f, s1 = 0.f;
#pragma unroll
        for (int j = 0; j < 8; ++j) { s0 += dot4(v0[j], v0[j]); s1 += dot4(v1[j], v1[j]); }
        const float r0 = 1.0f / sqrtf(wave_sum(s0) * (1.0f / DM) + EPS), r1 = 1.0f / sqrtf(wave_sum(s1) * (1.0f / DM) + EPS);
        { v4u* o16 = (v4u*)(A.H() + (size_t)m0 * DM) + F.lane;
#pragma unroll
          for (int j = 0; j < 4; ++j) { const f32x4 ha = v0[2 * j] * r0 * a1[2 * j] + sh[2 * j], hb = v0[2 * j + 1] * r0 * a1[2 * j + 1] + sh[2 * j + 1];
              o16[64 * j] = (v4u){pg8::cvt_pk_bf16(ha.x, ha.y), pg8::cvt_pk_bf16(ha.z, ha.w), pg8::cvt_pk_bf16(hb.x, hb.y), pg8::cvt_pk_bf16(hb.z, hb.w)}; } }
        if (has1) { v4u* o16 = (v4u*)(A.H() + (size_t)m1 * DM) + F.lane;
#pragma unroll
          for (int j = 0; j < 4; ++j) { const f32x4 ha = v1[2 * j] * r1 * a1[2 * j] + sh[2 * j], hb = v1[2 * j + 1] * r1 * a1[2 * j + 1] + sh[2 * j + 1];
              o16[64 * j] = (v4u){pg8::cvt_pk_bf16(ha.x, ha.y), pg8::cvt_pk_bf16(ha.z, ha.w), pg8::cvt_pk_bf16(hb.x, hb.y), pg8::cvt_pk_bf16(hb.z, hb.w)}; } }
        else if (m1 < NTOK) { m0 -= NGW; }
    }
}

__device__ __forceinline__ float sigmoidf_(float v) { return __builtin_amdgcn_rcpf(1.0f + __expf(-v)); }
constexpr size_t OTILE_PITCH = 65536 + 128;
struct EpiStoreFrag {
    static constexpr bool PERM = true, AFTER_DRAIN = false;
    bf16* O; int ntn;
    __device__ __forceinline__ void operator()(const pg8::f32x4 (&acc)[2][2][4][2], const pg8::Unit& u, int wr, int wc, int fr, int fq) const {
        bf16* base = O + ((size_t)(u.pm * ntn + u.pn) * OTILE_PITCH) + (size_t)((wr * 4 + wc) * 16) * 512 + (fq * 16 + fr) * 8;
#pragma unroll
        for (int ai = 0; ai < 2; ++ai)
#pragma unroll
            for (int m = 0; m < 4; ++m)
#pragma unroll
                for (int bj = 0; bj < 2; ++bj) { const pg8::f32x4 v0 = acc[ai][bj][m][0], v1 = acc[ai][bj][m][1];
                    v4u w; w.x = pg8::cvt_pk_bf16(v0[0], v0[1]); w.y = pg8::cvt_pk_bf16(v0[2], v0[3]); w.z = pg8::cvt_pk_bf16(v1[0], v1[1]); w.w = pg8::cvt_pk_bf16(v1[2], v1[3]);
                    *(v4u*)(base + ((ai * 4 + m) * 2 + bj) * 512) = w; }
    }
};
struct EpiInProj {
    static constexpr bool PERM = true, AFTER_DRAIN = false;
    bf16* P;
    __device__ __forceinline__ void operator()(const pg8::f32x4 (&acc)[2][2][4][2], const pg8::Unit& u, int wr, int wc, int fr, int fq) const {
        unsigned char* pmb = (unsigned char*)P + (size_t)u.pm * 1572864; const int rowt = wr * 64 + fr;
        if (u.pn < 4) {
            unsigned char* tb = pmb + u.pn * 131072 + (wc * 32 + 8 * fq) * 2;
#pragma unroll
            for (int ai = 0; ai < 2; ++ai)
#pragma unroll
                for (int m = 0; m < 4; ++m) { unsigned char* rowp = tb + (size_t)(rowt + ai * 128 + m * 16) * 512;
#pragma unroll
                    for (int bj = 0; bj < 2; ++bj) { const pg8::f32x4 v0 = acc[ai][bj][m][0], v1 = acc[ai][bj][m][1];
                        v4u w; w.x = pg8::cvt_pk_bf16(v0[0], v0[1]); w.y = pg8::cvt_pk_bf16(v0[2], v0[3]); w.z = pg8::cvt_pk_bf16(v1[0], v1[1]); w.w = pg8::cvt_pk_bf16(v1[2], v1[3]);
                        __builtin_nontemporal_store(w, (v4u*)(rowp + bj * 256)); } }
        } else {
            const bool glu = u.pn >= 12;
            unsigned char* tb = pmb + (glu ? 1048576 + (u.pn - 12) * 65536 : 524288 + (u.pn - 4) * 65536) + (wc * 32 + 8 * fq) * 2;
#pragma unroll
            for (int ai = 0; ai < 2; ++ai)
#pragma unroll
                for (int m = 0; m < 4; ++m) { unsigned char* rowp = tb + (size_t)(rowt + ai * 128 + m * 16) * 256;
                    pg8::f32x4 a0 = acc[ai][0][m][0], a1 = acc[ai][0][m][1]; const pg8::f32x4 b0 = acc[ai][1][m][0], b1 = acc[ai][1][m][1];
                    if (glu) {
#pragma unroll
                        for (int i = 0; i < 4; ++i) { a0[i] *= sigmoidf_(b0[i]); a1[i] *= sigmoidf_(b1[i]); }
                    } else { a0 = a0 * b0; a1 = a1 * b1; }
                    v4u w; w.x = pg8::cvt_pk_bf16(a0[0], a0[1]); w.y = pg8::cvt_pk_bf16(a0[2], a0[3]); w.z = pg8::cvt_pk_bf16(a1[0], a1[1]); w.w = pg8::cvt_pk_bf16(a1[2], a1[3]);
                    __builtin_nontemporal_store(w, (v4u*)rowp); }
        }
    }
};

__device__ __forceinline__ void p3_mix(const Frame& F, const Args& A) {
    LAS float* stats = (LAS float*)(F.lds + RING_OFF);
    LAS float* fin = (LAS float*)(F.lds + RING_OFF + 4096);
    const int tid = F.tid, ch = 2 * tid;
    float ca[3][2]; f32x2 cb[31];
#pragma unroll
    for (int k = 0; k < 3; ++k) { ca[k][0] = A.conv_a()[k * DCA + ch]; ca[k][1] = A.conv_a()[k * DCA + ch + 1]; }
#pragma unroll
    for (int k = 0; k < 31; ++k) cb[k] = (f32x2){A.conv_b()[k * DCA + ch], A.conv_b()[k * DCA + ch + 1]};
    const float na0 = A.norm_a()[ch], na1 = A.norm_a()[ch + 1], bb0 = A.conv_b_bias()[ch], bb1 = A.conv_b_bias()[ch + 1];
    const float lg0 = A.ln_g()[ch], lg1 = A.ln_g()[ch + 1], lb0 = A.ln_b()[ch], lb1 = A.ln_b()[ch + 1];
    const __amdgpu_buffer_rsrc_t Prs = __builtin_amdgcn_make_buffer_rsrc((void*)A.P(), 0, (int)((size_t)NTOK * PW * 2), 0x00020000);
    const __amdgpu_buffer_rsrc_t Yrs = __builtin_amdgcn_make_buffer_rsrc((void*)A.Y(), 0, (int)((size_t)NTOK * DM * 2), 0x00020000);
    const int vo = 4 * tid;
    const int voB = (tid >> 7) * 131072 + 4 * (tid & 127), voC = 524288 + (tid >> 6) * 65536 + 4 * (tid & 63), voU = voC + 524288;
#define P3_LDB(t) __builtin_amdgcn_raw_buffer_load_b32(Prs, voB, ((t) >> 8) * 1572864 + ((t) & 255) * 512, 0)
#define P3_LDC(t) __builtin_amdgcn_raw_buffer_load_b32(Prs, voC, ((t) >> 8) * 1572864 + ((t) & 255) * 256, 0)
#define P3_LDU(t) __builtin_amdgcn_raw_buffer_load_b32(Prs, voU, ((t) >> 8) * 1572864 + ((t) & 255) * 256, 0)
#define P3_ST(v, t, cb_) __builtin_amdgcn_raw_buffer_store_b32((v), Yrs, vo, (t) * 4096 + (cb_), 0)
    for (int tile = blockIdx.x; tile < NTOK / 128; tile += F.G) {
        const int t0 = tile * 128; const bool first = (t0 & (SEQ - 1)) == 0;
        f32x2 wb[32];
        wb[0] = (f32x2){0.f, 0.f}; wb[1] = (f32x2){0.f, 0.f};
#pragma unroll
        for (int s = 2; s < 32; ++s) { unsigned uu = 0u; if (!first) uu = P3_LDU(t0 - 32 + s); wb[s] = (f32x2){bf_lo(uu), bf_hi(uu)}; }
        float cm1[2], cm2[2];
        { unsigned u1 = 0u, u2 = 0u; if (!first) { u1 = P3_LDC(t0 - 1); u2 = P3_LDC(t0 - 2); }
          cm1[0] = bf_lo(u1); cm1[1] = bf_hi(u1); cm2[0] = bf_lo(u2); cm2[1] = bf_hi(u2); }
        unsigned nb[8], nc[8], nu[8];
#pragma unroll
        for (int s = 0; s < 8; ++s) { nb[s] = P3_LDB(t0 + s); nc[s] = P3_LDC(t0 + s); nu[s] = P3_LDU(t0 + s); }
        for (int blk = 0; blk < 4; ++blk) {
#pragma unroll
            for (int sub = 0; sub < 4; ++sub) {
                const int par = sub & 1;
                const int tb = t0 + 32 * blk + 8 * sub;
                unsigned pb[8], pc[8], pu[8];
#pragma unroll
                for (int s = 0; s < 8; ++s) { pb[s] = nb[s]; pc[s] = nc[s]; pu[s] = nu[s]; }
#pragma unroll
                for (int s = 0; s < 8; ++s) { nb[s] = P3_LDB(tb + 8 + s); nc[s] = P3_LDC(tb + 8 + s); nu[s] = P3_LDU(tb + 8 + s); }
                float vk[8][2];
#pragma unroll
                for (int s = 0; s < 8; ++s) {
                    const int S = 8 * sub + s;
                    const float c0 = bf_lo(pc[s]), c1 = bf_hi(pc[s]);
                    const float ya0 = bf_lo(pb[s]) * (ca[0][0] * cm2[0] + ca[1][0] * cm1[0] + ca[2][0] * c0);
                    const float ya1 = bf_hi(pb[s]) * (ca[0][1] * cm2[1] + ca[1][1] * cm1[1] + ca[2][1] * c1);
                    cm2[0] = cm1[0]; cm2[1] = cm1[1]; cm1[0] = c0; cm1[1] = c1;
                    wb[S] = (f32x2){bf_lo(pu[s]), bf_hi(pu[s])};
                    f32x2 av = (f32x2){bb0, bb1}, aw = (f32x2){0.f, 0.f};
#pragma unroll
                    for (int k = 0; k < 30; k += 2) { av = __builtin_elementwise_fma(cb[k], wb[(S + 2 + k) & 31], av); aw = __builtin_elementwise_fma(cb[k + 1], wb[(S + 3 + k) & 31], aw); }
                    av = __builtin_elementwise_fma(cb[30], wb[S], av) + aw;
                    const float a0 = av.x, a1 = av.y;
                    vk[s][0] = a0; vk[s][1] = a1;
                    float ssa = ya0 * ya0 + ya1 * ya1, s1 = a0 + a1, s2 = a0 * a0 + a1 * a1;
                    wave_sum3_dpp(ssa, s1, s2);
                    const float ra = __builtin_amdgcn_rsqf(ssa * (1.0f / 128.0f) + EPS);
                    P3_ST(cvt2bf(ya0 * ra * na0, ya1 * ra * na1), tb + s, 0);
                    if (F.lane == 0) { stats[((par * 8 + s) * 8 + F.wave) * 2 + 0] = s1; stats[((par * 8 + s) * 8 + F.wave) * 2 + 1] = s2; }
                }
                LDS_WAIT(); __builtin_amdgcn_s_barrier(); asm volatile("" ::: "memory");
                if (tid < 8) { float q1 = 0.f, q2 = 0.f;
#pragma unroll
                    for (int w = 0; w < 8; ++w) { q1 += stats[((par * 8 + tid) * 8 + w) * 2 + 0]; q2 += stats[((par * 8 + tid) * 8 + w) * 2 + 1]; }
                    const float mean = q1 * (1.0f / 1024.0f); float var = q2 * (1.0f / 1024.0f) - mean * mean; var = var > 0.f ? var : 0.f;
                    fin[(par * 8 + tid) * 2 + 0] = mean; fin[(par * 8 + tid) * 2 + 1] = __builtin_amdgcn_rsqf(var + EPS); }
                LDS_WAIT(); __builtin_amdgcn_s_barrier(); asm volatile("" ::: "memory");
#pragma unroll
                for (int s = 0; s < 8; ++s) { const float mean = fin[(par * 8 + s) * 2 + 0], rstd = fin[(par * 8 + s) * 2 + 1];
                    const float z0 = (vk[s][0] - mean) * rstd * lg0 + lb0, z1 = (vk[s][1] - mean) * rstd * lg1 + lb1;
                    P3_ST(cvt2bf(z0 * sigmoidf_(z0), z1 * sigmoidf_(z1)), tb + s, 2048); }
            }
        }
    }
#undef P3_LDB
#undef P3_LDC
#undef P3_LDU
#undef P3_ST
}

constexpr int P5_OFF_PV = 0;
constexpr int P5_OFF_RED = 24576;
constexpr int P5_OFF_PART = 25600;
constexpr int P5_OFF_LOG = 66560;
constexpr int P5_OFF_REC = 71680;
constexpr int P5_OFF_CNT = 88064;
constexpr int P5_MAXREC = 1024;
__device__ __forceinline__ void p5_params(const Frame& F, const Args& A, int b) {
    LAS float* pv = (LAS float*)(F.lds + RING_OFF + P5_OFF_PV); const float* modb = A.mod() + b * NMODC;
    for (int k = F.tid; k < DM; k += NWAVES * 64) { pv[k] = modb[2 * DM + k] * A.g_post1()[k]; pv[DM + k] = A.g_pre2()[k] * (modb[4 * DM + k] + 1.0f); pv[2 * DM + k] = modb[3 * DM + k]; }
}
#define P5_BAR() do { LDS_WAIT(); __builtin_amdgcn_s_barrier(); asm volatile("" ::: "memory"); } while (0)
__device__ __forceinline__ void p5_norm2_router(const Frame& F, const Args& A) {
    const int lane = F.lane, w = F.wave, r = lane & 15, q = lane >> 4, kb = 256 * w, ko = kb + 16 * q;
    LAS float* pv = (LAS float*)(F.lds + RING_OFF + P5_OFF_PV);
    LAS float* red1 = (LAS float*)(F.lds + RING_OFF + P5_OFF_RED); LAS float* red2 = red1 + 128;
    LAS float* part = (LAS float*)(F.lds + RING_OFF + P5_OFF_PART);
    LAS float* lg = (LAS float*)(F.lds + RING_OFF + P5_OFF_LOG);
    LAS int* rec_e = (LAS int*)(F.lds + RING_OFF + P5_OFF_REC); LAS int* rec_a = rec_e + P5_MAXREC; LAS int* rec_p = rec_a + P5_MAXREC; LAS float* rec_w = (LAS float*)(rec_p + P5_MAXREC);
    LAS int* lcnt = (LAS int*)(F.lds + RING_OFF + P5_OFF_CNT); LAS int* lbase = lcnt + 64;
    if (F.tid < 64) lcnt[F.tid] = 0;
    const int tpb = (NTOK / 16 + F.G - 1) / F.G;
    int bcur = -1, nrec = 0;
    for (int i = 0; i < tpb; ++i) {
        const int tile = (int)blockIdx.x * tpb + i; if (tile >= NTOK / 16) break;
        const int mt0 = tile * 16, b = mt0 >> 14, m = mt0 + r;
        const float* xrow = A.x() + (size_t)m * DM + ko;
        const int oidx = (mt0 >> 4) & 15;
        const bf16* otile = A.O() + (size_t)((mt0 >> 8) * 8 + w) * OTILE_PITCH + (size_t)(((oidx >> 2) & 1) * 64 * 512) + (size_t)(((oidx >> 3) * 4 + (oidx & 3)) * 2) * 512 + (size_t)r * 8;
        f32x4 xv[4][4]; v4u ov[4][2];
#pragma unroll
        for (int cg = 0; cg < 4; ++cg) {
#pragma unroll
            for (int j = 0; j < 4; ++j) xv[cg][j] = *(const f32x4*)(xrow + 64 * cg + 4 * j);
#pragma unroll
            for (int hh = 0; hh < 2; ++hh) { const int wcq = (2 * cg + (q >> 1)) & 3, fqq = 2 * (q & 1) + hh;
                ov[cg][hh] = *(const v4u*)(otile + (size_t)(wcq * 16 + (cg >> 1)) * 512 + fqq * 128); } }
        if (b != bcur) { P5_BAR(); p5_params(F, A, b); bcur = b; P5_BAR(); }
        float so = 0.f;
#pragma unroll
        for (int cg = 0; cg < 4; ++cg)
#pragma unroll
            for (int hh = 0; hh < 2; ++hh) { const v4u p = ov[cg][hh]; const f32x4 va = (f32x4){bf_lo(p.x), bf_hi(p.x), bf_lo(p.y), bf_hi(p.y)}, vb = (f32x4){bf_lo(p.z), bf_hi(p.z), bf_lo(p.w), bf_hi(p.w)};
                so += dot4(va, va) + dot4(vb, vb); }
        so += __shfl_xor(so, 16); so += __shfl_xor(so, 32);
        if (q == 0) red1[w * 16 + r] = so;
        P5_BAR();
        float to = 0.f;
#pragma unroll
        for (int ww = 0; ww < 8; ++ww) to += red1[ww * 16 + r];
        const float ro = 1.0f / sqrtf(to * (1.0f / DM) + EPS);
        bf16* x1row = A.X1() + (size_t)m * DM + ko; float sx = 0.f;
#pragma unroll
        for (int cg = 0; cg < 4; ++cg)
#pragma unroll
            for (int hh = 0; hh < 2; ++hh) { const v4u p = ov[cg][hh]; const f32x4 va = (f32x4){bf_lo(p.x), bf_hi(p.x), bf_lo(p.y), bf_hi(p.y)}, vb = (f32x4){bf_lo(p.z), bf_hi(p.z), bf_lo(p.w), bf_hi(p.w)};
                const f32x4 a1a = *(const LAS f32x4*)(pv + ko + 64 * cg + 8 * hh), a1b = *(const LAS f32x4*)(pv + ko + 64 * cg + 8 * hh + 4);
                const f32x4 x1a = xv[cg][2 * hh] + a1a * (va * ro), x1b = xv[cg][2 * hh + 1] + a1b * (vb * ro);
                xv[cg][2 * hh] = x1a; xv[cg][2 * hh + 1] = x1b;
                *(v4u*)(x1row + 64 * cg + 8 * hh) = (v4u){cvt2bf(x1a.x, x1a.y), cvt2bf(x1a.z, x1a.w), cvt2bf(x1b.x, x1b.y), cvt2bf(x1b.z, x1b.w)}; sx += dot4(x1a, x1a) + dot4(x1b, x1b); }
        sx += __shfl_xor(sx, 16); sx += __shfl_xor(sx, 32);
        if (q == 0) red2[w * 16 + r] = sx;
        P5_BAR();
        float tx = 0.f;
#pragma unroll
        for (int ww = 0; ww < 8; ++ww) tx += red2[ww * 16 + r];
        const float r1 = 1.0f / sqrtf(tx * (1.0f / DM) + EPS);
        unsigned char* hrow = A.H8() + (size_t)m * DM + ko;
        const __amdgpu_buffer_rsrc_t wrs = __builtin_amdgcn_make_buffer_rsrc((void*)A.WR(), 0, 8 * 8 * 5 * 1024, 0x00020000);
#define P5_LDB(c, f) __builtin_bit_cast(f16x8_, __builtin_amdgcn_raw_buffer_load_b128(wrs, lane * 16, ((w * 8 + (c)) * 5 + (f)) * 1024, 0))
        f32x4 acc[5];
#pragma unroll
        for (int nf = 0; nf < 5; ++nf) acc[nf] = (f32x4){0.f, 0.f, 0.f, 0.f};
        f16x8_ bq[5], b1[5], b2[5];
#pragma unroll
        for (int f = 0; f < 5; ++f) { b1[f] = P5_LDB(0, f); b2[f] = P5_LDB(1, f); }
#pragma unroll
        for (int cg = 0; cg < 4; ++cg) {
            unsigned h8[4];
#pragma unroll
            for (int hh = 0; hh < 2; ++hh) {
                const int c = 2 * cg + hh;
#pragma unroll
                for (int f = 0; f < 5; ++f) { bq[f] = b1[f]; b1[f] = b2[f]; }
                if (c + 2 < 8) {
#pragma unroll
                    for (int f = 0; f < 5; ++f) b2[f] = P5_LDB(c + 2, f);
                }
                const f32x4 a2a = *(const LAS f32x4*)(pv + DM + ko + 64 * cg + 8 * hh), a2b = *(const LAS f32x4*)(pv + DM + ko + 64 * cg + 8 * hh + 4);
                const f32x4 a3a = *(const LAS f32x4*)(pv + 2 * DM + ko + 64 * cg + 8 * hh), a3b = *(const LAS f32x4*)(pv + 2 * DM + ko + 64 * cg + 8 * hh + 4);
                const f32x4 ha = xv[cg][2 * hh] * r1 * a2a + a3a, hb = xv[cg][2 * hh + 1] * r1 * a2b + a3b;
                h8[2 * hh] = pk4_fp8(ha.x * SC_H, ha.y * SC_H, ha.z * SC_H, ha.w * SC_H); h8[2 * hh + 1] = pk4_fp8(hb.x * SC_H, hb.y * SC_H, hb.z * SC_H, hb.w * SC_H);
                const unsigned h0 = pkh2(ha.x, ha.y), h1 = pkh2(ha.z, ha.w), h2 = pkh2(hb.x, hb.y), h3 = pkh2(hb.z, hb.w);
                const unsigned l0 = pkh2(ha.x - h_lo(h0), ha.y - h_hi(h0)), l1 = pkh2(ha.z - h_lo(h1), ha.w - h_hi(h1)), l2 = pkh2(hb.x - h_lo(h2), hb.y - h_hi(h2)), l3 = pkh2(hb.z - h_lo(h3), hb.w - h_hi(h3));
                const f16x8_ ahi = __builtin_bit_cast(f16x8_, (v4u){h0, h1, h2, h3}), alo = __builtin_bit_cast(f16x8_, (v4u){l0, l1, l2, l3});
#pragma unroll
                for (int nf = 0; nf < 5; ++nf) { acc[nf] = __builtin_amdgcn_mfma_f32_16x16x32_f16(ahi, bq[nf], acc[nf], 0, 0, 0); acc[nf] = __builtin_amdgcn_mfma_f32_16x16x32_f16(alo, bq[nf], acc[nf], 0, 0, 0); }
            }
            *(v4u*)(hrow + 64 * cg) = (v4u){h8[0], h8[1], h8[2], h8[3]};
        }
#undef P5_LDB
#pragma unroll
        for (int nf = 0; nf < 5; ++nf)
#pragma unroll
            for (int ii = 0; ii < 4; ++ii) part[(w * 16 + 4 * q + ii) * 80 + 16 * nf + r] = acc[nf][ii];
        P5_BAR();
        for (int p = F.tid; p < 16 * 80; p += NWAVES * 64) { const int tok = p / 80, n = p - tok * 80; float sum = 0.f;
#pragma unroll
            for (int ww = 0; ww < 8; ++ww) sum += part[(ww * 16 + tok) * 80 + n];
            lg[p] = sum; }
        P5_BAR();
        if (F.tid < 16) {
            const LAS float* L = lg + F.tid * 80;
            float ac[8];
#pragma unroll
            for (int n = 0; n < 8; ++n) ac[n] = L[n] + A.b_rg()[n];
            int g = 0; float mx = ac[0];
#pragma unroll
            for (int n = 1; n < 8; ++n) if (ac[n] > mx) { mx = ac[n]; g = n; }
            float se = 0.f;
#pragma unroll
            for (int n = 0; n < 8; ++n) se += expf(ac[n] - mx);
            const float pg = 1.0f / se;
            float af[8];
#pragma unroll
            for (int n = 0; n < 8; ++n) af[n] = L[8 + 8 * g + n] + A.b_re()[g * 8 + n];
            int i0 = 0; float v0 = af[0];
#pragma unroll
            for (int n = 1; n < 8; ++n) if (af[n] > v0) { v0 = af[n]; i0 = n; }
            int i1 = -1; float v1 = 0.f;
#pragma unroll
            for (int n = 0; n < 8; ++n) if (n != i0 && (i1 < 0 || af[n] > v1)) { v1 = af[n]; i1 = n; }
            const float ee = expf(v1 - v0), w0 = 1.0f / (1.0f + ee), w1 = ee / (1.0f + ee);
            const int e0 = g * 8 + i0, e1 = g * 8 + i1, mm = mt0 + F.tid, ix = nrec + 2 * F.tid;
            rec_e[ix] = e0; rec_a[ix] = 2 * mm; rec_w[ix] = pg * w0; rec_p[ix] = __hip_atomic_fetch_add(lcnt + e0, 1, __ATOMIC_RELAXED, __HIP_MEMORY_SCOPE_WORKGROUP);
            rec_e[ix + 1] = e1; rec_a[ix + 1] = 2 * mm + 1; rec_w[ix + 1] = pg * w1; rec_p[ix + 1] = __hip_atomic_fetch_add(lcnt + e1, 1, __ATOMIC_RELAXED, __HIP_MEMORY_SCOPE_WORKGROUP);
        }
        nrec += 32;
    }
    P5_BAR();
    if (F.tid < 64) { const int n = lcnt[F.tid]; lbase[F.tid] = n > 0 ? (int)__hip_atomic_fetch_add(A.ctl() + CW_CNT + 64 * F.tid, (unsigned)n, RLX_AGENT) : 0; }
    P5_BAR();
    for (int ix = F.tid; ix < nrec; ix += NWAVES * 64) { const int e = rec_e[ix], slot = lbase[e] + rec_p[ix];
        A.lista()[(size_t)e * LISTCAP + slot] = (int)((unsigned)rec_a[ix] | (cvt2bf(0.f, rec_w[ix]) & 0xffff0000u)); }
}
#undef P5_BAR

struct MUnit { int e, mt, nt, cnt, prow, half; };
constexpr int MOE_MAXU = 24;
__device__ __forceinline__ void moe_tables(const Frame& F, const Args& A) {
    LAS int* T = (LAS int*)(F.lds + TAB_OFF);
    if (F.tid < 64) {
        const int c = (int)__hip_atomic_load(A.ctl() + CW_CNT + 64 * F.tid, RLX_AGENT), full = c >> 8, rem = c & 255;
        int rows = ((c + 255) >> 8) << 8, ua = (full + (rem > 128 ? 1 : 0)) * 8, ub = (rem > 0 && rem <= 128) ? 8 : 0;
        const int rows0 = rows, ua0 = ua, ub0 = ub;
#pragma unroll
        for (int o = 1; o < 64; o <<= 1) { const int r1 = __shfl_up(rows, o), a1 = __shfl_up(ua, o), b1 = __shfl_up(ub, o); if (F.lane >= o) { rows += r1; ua += a1; ub += b1; } }
        T[F.tid] = c; T[64 + F.tid] = rows - rows0; T[128 + F.tid] = ua - ua0; T[200 + F.tid] = ub - ub0;
        if (F.tid == 63) { T[128 + 64] = ua; T[200 + 64] = ub; } }
    __syncthreads();
    const int G = F.G, bx = (int)blockIdx.x, rk = (G % 8 == 0) ? (bx % 8) * (G / 8) + bx / 8 : bx;
    const int UA = T[192], UB = T[264], nu = (UA + UB > rk) ? (UA + UB - rk + G - 1) / G : 0;
    if (F.tid == 0) T[270] = nu < MOE_MAXU ? nu : MOE_MAXU;
    if (F.tid < MOE_MAXU && F.tid < nu) {
        const int p = F.tid * G + rk; int e = 0, mt, nt, half;
        if (p < UA) { for (int q = 1; q < NEXP; ++q) if (p >= T[128 + q]) e = q; const int l = p - T[128 + e]; mt = l >> 3; nt = l & 7; half = 0; }
        else { const int pp = p - UA; for (int q = 1; q < NEXP; ++q) if (pp >= T[200 + q]) e = q; mt = T[e] >> 8; nt = (pp - T[200 + e]) & 7; half = 1; }
        LAS int* d = T + 272 + 4 * F.tid; d[0] = e; d[1] = mt; d[2] = nt; d[3] = half; }
    __syncthreads();
}
struct MoeSched {
    const LAS int* T;
    __device__ __forceinline__ bool next(int i, MUnit& u) const {
        if (i >= T[270]) return false;
        const LAS int* d = T + 272 + 4 * i; const int e = d[0], mt = d[1];
        u.e = __builtin_amdgcn_readfirstlane(e); u.mt = __builtin_amdgcn_readfirstlane(mt); u.nt = __builtin_amdgcn_readfirstlane(d[2]); u.half = __builtin_amdgcn_readfirstlane(d[3]);
        u.cnt = __builtin_amdgcn_readfirstlane(T[e]); u.prow = __builtin_amdgcn_readfirstlane(T[64 + e] + 256 * mt); return true;
    }
};
typedef int v4i_ __attribute__((ext_vector_type(4)));
typedef int v8i_ __attribute__((ext_vector_type(8)));
struct EpiGateUp8 {
    static constexpr bool HAS_PRE = false;
    unsigned char* HID;
    __device__ __forceinline__ void pre(const MUnit&, int, int, int (&)[8]) const {}
    __device__ __forceinline__ void operator()(const pg8::f32x4 (&acc)[2][2][4][2], const MUnit& u, int wr, int wc, int fr, int fq, const int (&)[8]) const {
        unsigned char* tile = HID + ((size_t)(u.prow >> 8) * 8 + u.nt) * 32768; const int rowt = wr * 64 + fr, colt = wc * 32 + 8 * fq; const float sc = 1.0f / (SC_H * SC_WGU);
#pragma unroll
        for (int ai = 0; ai < 2; ++ai) { if (ai == 1 && u.half) break;
#pragma unroll
            for (int m = 0; m < 4; ++m) { unsigned char* rowp = tile + (size_t)(rowt + ai * 128 + m * 16) * 128 + colt;
                pg8::f32x4 a0 = acc[ai][0][m][0] * sc, a1 = acc[ai][0][m][1] * sc; const pg8::f32x4 b0 = acc[ai][1][m][0] * (sc * SC_HID), b1 = acc[ai][1][m][1] * (sc * SC_HID);
#pragma unroll
                for (int i = 0; i < 4; ++i) { a0[i] = a0[i] * sigmoidf_(a0[i]) * b0[i]; a1[i] = a1[i] * sigmoidf_(a1[i]) * b1[i]; }
                *(v2u*)rowp = (v2u){pk4_fp8(a0[0], a0[1], a0[2], a0[3]), pk4_fp8(a1[0], a1[1], a1[2], a1[3])}; } }
    }
};
struct EpiDown8 {
    static constexpr bool HAS_PRE = true;
    bf16* YD; const int* lrec;
    __device__ __forceinline__ void pre(const MUnit& u, int wr, int fr, int (&pa)[8]) const {
#pragma unroll
        for (int ai = 0; ai < 2; ++ai)
#pragma unroll
            for (int m = 0; m < 4; ++m) { const int s = 256 * u.mt + ai * 128 + wr * 64 + m * 16 + fr; const int sc = s < u.cnt ? s : 0;
                pa[ai * 4 + m] = lrec[(size_t)u.e * LISTCAP + sc]; }
    }
    __device__ __forceinline__ void operator()(const pg8::f32x4 (&acc)[2][2][4][2], const MUnit& u, int wr, int wc, int fr, int fq, const int (&pa)[8]) const {
        const int col0 = u.nt * 256 + wc * 32 + 8 * fq;
#pragma unroll
        for (int ai = 0; ai < 2; ++ai)
#pragma unroll
            for (int m = 0; m < 4; ++m) { const int s = 256 * u.mt + ai * 128 + wr * 64 + m * 16 + fr;
                if (s < u.cnt) { const unsigned rc = (unsigned)pa[ai * 4 + m]; const int a = (int)(rc & 0xffffu); const float wgt = bf_hi(rc) * (1.0f / (SC_HID * SC_WD));
                    bf16* rowp = YD + (size_t)a * DM + col0;
#pragma unroll
                    for (int bj = 0; bj < 2; ++bj) { const pg8::f32x4 v0 = acc[ai][bj][m][0] * wgt, v1 = acc[ai][bj][m][1] * wgt;
                        v4u w; w.x = pg8::cvt_pk_bf16(v0[0], v0[1]); w.y = pg8::cvt_pk_bf16(v0[2], v0[3]); w.z = pg8::cvt_pk_bf16(v1[0], v1[1]); w.w = pg8::cvt_pk_bf16(v1[2], v1[3]);
                        *(v4u*)(rowp + bj * 128) = w; } } }
    }
};

template <class Epi, bool GATHER>
__device__ __forceinline__ void gemm_phase_moe8(LAS unsigned char* lds, const unsigned char* Abase, const unsigned char* Wbase, const int KB, const int* lista, const MoeSched& S, const Epi& E, const int wave_id) {
    using namespace pg8;
    int tid_ = wave_id * 64 + lane_id_fresh();
    const int tid = tid_, wid = __builtin_amdgcn_readfirstlane(tid >> 6), lane = tid & 63, wr = wid >> 2, wc = wid & 3, fr = lane & 15, fq = lane >> 4;
    const int nt = KB / 128;
    int Rr[2], Cc[2]; unsigned voffB[2];
#pragma unroll
    for (int i = 0; i < 2; ++i) { int R, C; stage_rc(tid * 16 + i * 8192, R, C); const int Rb = (R & ~31) + perm32(R & 31); Rr[i] = R; Cc[i] = C; voffB[i] = (unsigned)(Rb * 128 + C * 2); }
    const size_t kstep = GATHER ? 128 : 32768;
    const size_t kstepB = (size_t)2048 * 128, hstep = (size_t)HALF * 128;
    const unsigned ldsw = (unsigned)wid * 1024u;
    const int aoff = lds_byte(wr * 64 + fr, fq * 8), boff = lds_byte(wc * 32 + fr, fq * 8);
#define PG8_SA(b, h) (((b) * 2 + (h)) * HTB)
#define PG8_SB(b, h) ((4 + (b) * 2 + (h)) * HTB)
#define PG8_STAGE(bufoff, gbase, voff) do { _Pragma("unroll") for (int _i = 0; _i < 2; ++_i) \
        __builtin_amdgcn_global_load_lds((const unsigned*)((const char*)(gbase) + (voff)[_i]), (PG8_LAS unsigned*)(lds + (bufoff) + ldsw + _i * 8192), 16, 0, 0); } while (0)
#define PG8_STAGE2(bufoff, gbase, o0, o1) do { \
        __builtin_amdgcn_global_load_lds((const unsigned*)((const char*)(gbase) + (o0)), (PG8_LAS unsigned*)(lds + (bufoff) + ldsw), 16, 0, 0); \
        __builtin_amdgcn_global_load_lds((const unsigned*)((const char*)(gbase) + (o1)), (PG8_LAS unsigned*)(lds + (bufoff) + ldsw + 8192), 16, 0, 0); } while (0)
#define PG8_LDA(dst, b, h) do { _Pragma("unroll") for (int m = 0; m < 4; ++m) dst[m] = PG8_CAT(*(const PG8_LAS v4i_*)(lds + PG8_SA(b, h) + aoff + m * 2048), *(const PG8_LAS v4i_*)(lds + PG8_SA(b, h) + aoff + m * 2048 + 1024)); } while (0)
#define PG8_LDB(dst, b, h) do { _Pragma("unroll") for (int n = 0; n < 2; ++n) dst[n] = PG8_CAT(*(const PG8_LAS v4i_*)(lds + PG8_SB(b, h) + boff + n * 2048), *(const PG8_LAS v4i_*)(lds + PG8_SB(b, h) + boff + n * 2048 + 1024)); } while (0)
#define PG8_MMA(ai, bj, At, Bt) do { __builtin_amdgcn_s_setprio(1); _Pragma("unroll") for (int m = 0; m < 4; ++m) _Pragma("unroll") for (int n = 0; n < 2; ++n) \
        asm volatile("v_mfma_f32_16x16x128_f8f6f4 %0, %1, %2, %0" : "+v"(acc[ai][bj][m][n]) : "v"(Bt[n]), "v"(At[m])); __builtin_amdgcn_s_setprio(0); } while (0)
#define PG8_MFMA_DRAIN() asm volatile("s_nop 15\n\ts_nop 15" ::: "memory")
#define PG8_CAT(x, y) __builtin_shufflevector((x), (y), 0, 1, 2, 3, 4, 5, 6, 7)
#define PG8_WAIT_V(n) asm volatile("s_waitcnt vmcnt(" #n ")" ::: "memory")
#define PG8_WAIT_L(n) asm volatile("s_waitcnt lgkmcnt(" #n ")" ::: "memory")
#define PG8_BAR __builtin_amdgcn_s_barrier()
#define PG8_SCHED __builtin_amdgcn_sched_barrier(0)
#define MOE_ROWOFF(dst, u, h, i) do { const int _s = 256 * (u).mt + 128 * (h) + Rr[i]; \
        if (GATHER) { int _tok = 0; if (_s < (u).cnt) _tok = (lista[(size_t)(u).e * LISTCAP + _s] & 0xffff) >> 1; dst = (unsigned)_tok * (unsigned)KB + (unsigned)(Cc[i] * 2); } \
        else dst = (unsigned)((u).prow >> 8) * (unsigned)(KB * 256) + (unsigned)(128 * (h) + Rr[i]) * 128u + (unsigned)(Cc[i] * 2); } while (0)
    MUnit cur, nxt; int ui = 0;
    if (!S.next(0, cur)) return;
    f32x4 acc[2][2][4][2];
#pragma unroll
    for (int a = 0; a < 2; ++a)
#pragma unroll
        for (int b = 0; b < 2; ++b)
#pragma unroll
            for (int m = 0; m < 4; ++m)
#pragma unroll
                for (int n = 0; n < 2; ++n) acc[a][b][m][n] = (f32x4){0.f, 0.f, 0.f, 0.f};
    v8i_ At[4], B0[2], B1[2];
    unsigned c00, c01, c10, c11, n00, n01, n10, n11;
    MOE_ROWOFF(c00, cur, 0, 0); MOE_ROWOFF(c01, cur, 0, 1); MOE_ROWOFF(c10, cur, 1, 0); MOE_ROWOFF(c11, cur, 1, 1);
    const char* const cA = (const char*)Abase;
    const char* cB = (const char*)Wbase + (size_t)cur.e * 2048 * KB + (size_t)cur.nt * 32768;
    PG8_STAGE(PG8_SB(0, 0), cB, voffB); PG8_STAGE(PG8_SB(0, 1), cB + hstep, voffB); PG8_STAGE2(PG8_SA(0, 0), cA, c00, c01); PG8_STAGE2(PG8_SA(0, 1), cA, c10, c11);
    if (wr == 1) PG8_BAR;
    PG8_WAIT_V(2); PG8_BAR;
    PG8_STAGE(PG8_SB(1, 0), cB + kstepB, voffB); PG8_STAGE2(PG8_SA(1, 0), cA + kstep, c00, c01); PG8_STAGE(PG8_SB(1, 1), cB + hstep + kstepB, voffB);
    PG8_WAIT_V(6); PG8_BAR;
    for (;;) {
        const bool has_next = S.next(ui + 1, nxt);
        const char* nB = cB;
        n00 = c00; n01 = c01; n10 = c10; n11 = c11;
        if (has_next) { MOE_ROWOFF(n00, nxt, 0, 0); MOE_ROWOFF(n01, nxt, 0, 1); MOE_ROWOFF(n10, nxt, 1, 0); MOE_ROWOFF(n11, nxt, 1, 1);
            nB = (const char*)Wbase + (size_t)nxt.e * 2048 * KB + (size_t)nxt.nt * 32768; }
        int pa[8];
        const bool chalf = cur.half != 0;
        for (int t = 0; t < nt; t += 2) {
            const bool last = (t == nt - 2);
            const char* a1 = cA + (size_t)(t + 1) * kstep;
            const char* a2 = last ? cA : cA + (size_t)(t + 2) * kstep; const char* b2 = last ? nB : cB + (size_t)(t + 2) * kstepB;
            const char* a3 = a2 + kstep; const char* b3 = b2 + kstepB;
            unsigned x00 = c00, x01 = c01, x10 = c10, x11 = c11;
            if (last) { if (Epi::HAS_PRE) E.pre(cur, wr, fr, pa);
                asm volatile("" : "+v"(n00), "+v"(n01), "+v"(n10), "+v"(n11));
                x00 = n00; x01 = n01; x10 = n10; x11 = n11; }
            PG8_LDB(B0, 0, 0); PG8_LDB(B1, 0, 1); PG8_SCHED; PG8_LDA(At, 0, 0); PG8_STAGE2(PG8_SA(1, 1), a1, c10, c11);
            PG8_WAIT_V(8); PG8_WAIT_L(0); PG8_BAR; PG8_MMA(0, 0, At, B0); PG8_MMA(0, 1, At, B1); PG8_BAR; PG8_SCHED;
            if (!chalf) PG8_LDA(At, 0, 1);
            PG8_STAGE(PG8_SB(0, 0), b2, voffB); PG8_STAGE(PG8_SB(0, 1), b2 + hstep, voffB); PG8_STAGE2(PG8_SA(0, 0), a2, x00, x01);
            PG8_WAIT_V(8); PG8_WAIT_L(0); PG8_BAR; if (!chalf) { PG8_MMA(1, 0, At, B0); PG8_MMA(1, 1, At, B1); } PG8_BAR; PG8_SCHED;
            PG8_LDB(B0, 1, 0); PG8_LDB(B1, 1, 1); PG8_SCHED; PG8_LDA(At, 1, 0); PG8_STAGE2(PG8_SA(0, 1), a2, x10, x11);
            PG8_WAIT_V(8); PG8_WAIT_L(0); PG8_BAR; PG8_MMA(0, 0, At, B0); PG8_MMA(0, 1, At, B1); PG8_BAR; PG8_SCHED;
            if (!chalf) PG8_LDA(At, 1, 1);
            PG8_STAGE(PG8_SB(1, 0), b3, voffB); PG8_STAGE(PG8_SB(1, 1), b3 + hstep, voffB); PG8_STAGE2(PG8_SA(1, 0), a3, x00, x01);
            PG8_WAIT_V(8); PG8_WAIT_L(0); PG8_BAR; if (!chalf) { PG8_MMA(1, 0, At, B0); PG8_MMA(1, 1, At, B1); } PG8_BAR; PG8_SCHED;
        }
        if (wr == 0) PG8_BAR;
        PG8_MFMA_DRAIN();
        E(acc, cur, wr, wc, fr, fq, pa);
        if (!has_next) break;
#pragma unroll
        for (int a = 0; a < 2; ++a)
#pragma unroll
            for (int b = 0; b < 2; ++b)
#pragma unroll
                for (int m = 0; m < 4; ++m)
#pragma unroll
                    for (int n = 0; n < 2; ++n) acc[a][b][m][n] = (f32x4){0.f, 0.f, 0.f, 0.f};
        cur = nxt; cB = nB; c00 = n00; c01 = n01; c10 = n10; c11 = n11; ++ui;
        if (wr == 1) PG8_BAR;
    }
    PG8_WAIT_V(0);
    PG8_BAR;
#undef MOE_ROWOFF
#undef PG8_SA
#undef PG8_SB
#undef PG8_STAGE
#undef PG8_STAGE2
#undef PG8_LDA
#undef PG8_LDB
#undef PG8_MMA
#undef PG8_MFMA_DRAIN
#undef PG8_CAT
#undef PG8_WAIT_V
#undef PG8_WAIT_L
#undef PG8_BAR
#undef PG8_SCHED
}

__device__ __forceinline__ void p8_row_load(const Args& A, int m, int lane, f32x4 (&xv)[8], f32x4 (&yv)[8]) {
    const v2u* xr = (const v2u*)(A.X1() + (size_t)m * DM) + lane;
    const v2u* y0 = (const v2u*)(A.YD() + (size_t)(2 * m) * DM) + lane;
    const v2u* y1 = (const v2u*)(A.YD() + (size_t)(2 * m + 1) * DM) + lane;
#pragma unroll
    for (int j = 0; j < 8; ++j) { const v2u xx = xr[64 * j]; xv[j] = (f32x4){bf_lo(xx.x), bf_hi(xx.x), bf_lo(xx.y), bf_hi(xx.y)}; const v2u p = y0[64 * j], q = y1[64 * j];
        yv[j] = (f32x4){bf_lo(p.x) + bf_lo(q.x), bf_hi(p.x) + bf_hi(q.x), bf_lo(p.y) + bf_lo(q.y), bf_hi(p.y) + bf_hi(q.y)}; }
}
__device__ __forceinline__ void p8_row_finish(const Args& A, int m, int lane, const f32x4 (&xv)[8], const f32x4 (&yv)[8], const f32x4 (&gg)[8]) {
    float s = 0.f;
#pragma unroll
    for (int j = 0; j < 8; ++j) s += dot4(yv[j], yv[j]);
    const float r = 1.0f / sqrtf(wave_sum(s) * (1.0f / DM) + EPS);
    f32x4* outr = (f32x4*)(A.out() + (size_t)m * DM) + lane;
#pragma unroll
    for (int j = 0; j < 8; ++j) outr[64 * j] = xv[j] + gg[j] * (yv[j] * r);
}
__device__ __forceinline__ void p8_final(const Frame& F, const Args& A) {
    const int gw = F.vcu * NWAVES + F.wave, NGW = F.G * NWAVES, lane = F.lane;
    f32x4 gg[8]; int bcur = -1;
    for (int m0 = gw; m0 < NTOK; m0 += 2 * NGW) {
        const int m1 = m0 + NGW; const bool has1 = (m1 < NTOK) && ((m1 >> 14) == (m0 >> 14));
        f32x4 xa[8], ya[8], xb[8], yb[8];
        p8_row_load(A, m0, lane, xa, ya);
        p8_row_load(A, has1 ? m1 : m0, lane, xb, yb);
        if ((m0 >> 14) != bcur) { bcur = m0 >> 14; const f32x4* gp = (const f32x4*)A.g_post2() + lane; const f32x4* g2 = (const f32x4*)(A.mod() + bcur * NMODC + 5 * DM) + lane;
#pragma unroll
            for (int j = 0; j < 8; ++j) gg[j] = gp[64 * j] * g2[64 * j]; }
        p8_row_finish(A, m0, lane, xa, ya, gg);
        if (has1) p8_row_finish(A, m1, lane, xb, yb, gg);
        else if (m1 < NTOK) { m0 -= NGW; }
    }
}
#ifndef PHMASK
#define PHMASK 511
#endif
#ifndef GEMM2_SHARE
#define GEMM2_SHARE 27
#endif
#ifndef GEMM4_SHARE
#define GEMM4_SHARE 26
#endif
#ifndef REPMASK
#define REPMASK 0
#endif
#define REPS(k) (((REPMASK >> (k)) & 1) ? 2 : 1)

__global__ void __launch_bounds__(NWAVES * 64, 2) mk_fwd(Args args) {
    extern __shared__ __attribute__((aligned(16))) unsigned char lds[];
    Frame F;
    F.lds = (LAS unsigned char*)lds;
    F.tid = threadIdx.x; F.lane = F.tid & 63; F.wave = __builtin_amdgcn_readfirstlane(F.tid >> 6);
    F.G = gridDim.x; { const int bx = blockIdx.x; F.vcu = (F.G % 8 == 0) ? (bx % 8) * (F.G / 8) + bx / 8 : bx; }
    const Args& A = args;
    for (int u = F.tid; u < (LDS_BYTES - LDSCTL_OFF) / 4; u += NWAVES * 64) ((LAS unsigned*)(F.lds + LDSCTL_OFF))[u] = 0u;
    __syncthreads();
#ifdef TLSEL
    unsigned tl_acc = 0;
#define TL_NOW() ((unsigned)__builtin_amdgcn_s_memrealtime())
#define TL_AT(sel, ...) do { if (TLSEL == (sel)) { __VA_ARGS__; } } while (0)
#else
#define TL_AT(sel, ...) do {} while (0)
#endif
    XcdBarrier bar = xcd_barrier_post(A.ctl() + CW_BAR, (volatile LAS unsigned*)(F.lds + LDSCTL_OFF));

#if PHMASK & 1
    p0_ada(phase_frame(F), A); p0_router_weights(phase_frame(F), A); p0_weights(phase_frame(F), A);
#ifdef ISO_CONV
    __syncthreads(); if ((int)blockIdx.x >= ISO_CONV) expert_worker(phase_frame(F), A, 0u);
#endif
    if (REPS(0) == 2) { __syncthreads(); p0_ada(phase_frame(F), A); p0_weights(phase_frame(F), A); }
#endif
    xcd_barrier(bar, F.wave);
#if PHMASK & 2
    p1_norm1(phase_frame(F), A);
    if (REPS(1) == 2) p1_norm1(phase_frame(F), A);
#endif
    xcd_barrier(bar, F.wave);
#if PHMASK & 4
    {
        const int NG2 = (F.G % 8 == 0 && F.G >= 64) ? (F.G / 8 * GEMM2_SHARE / 32) * 8 : F.G;
        TL_AT(10, tl_acc -= TL_NOW()); TL_AT(13, tl_acc -= TL_NOW());
        if ((int)blockIdx.x < NG2) {
            pg8::Gemm g{A.H(), A.WIN(), NTOK, DINP, DM}; pg8::StaticOrder S; S.init(NTOK, DINP, NG2, (int)blockIdx.x);
            EpiInProj E{A.P()};
            pg8::gemm_phase<EpiInProj, pg8::StaticOrder, true, true>(F.lds + RING_OFF, g, S, E, F.wave);
            if (threadIdx.x == 0) __hip_atomic_fetch_add(A.ctl() + CW_DONE, 1u, RLX_AGENT);
        }
        TL_AT(13, tl_acc += TL_NOW());
        expert_worker(phase_frame(F), A, (unsigned)NG2);
        TL_AT(10, tl_acc += TL_NOW()); }
    if (REPS(2) == 2) {   pg8::Gemm g{A.H(), A.WIN(), NTOK, DINP, DM}; pg8::StaticOrder S; S.init(NTOK, DINP, F.G, (int)blockIdx.x);
        EpiInProj E{A.P()};
        pg8::gemm_phase<EpiInProj, pg8::StaticOrder, true, true>(F.lds + RING_OFF, g, S, E, F.wave); }
#endif
    xcd_barrier(bar, F.wave);
    TL_AT(12, { unsigned q = __hip_atomic_load(A.ctl() + CW_Q, RLX_AGENT); tl_acc = q < 12288u ? q : 12288u; });
#if PHMASK & 8
    p3_mix(phase_frame(F), A);
    if (REPS(3) == 2) p3_mix(phase_frame(F), A);
#endif
    xcd_barrier(bar, F.wave);
#if PHMASK & 16
    {
        const int NG2 = (F.G % 8 == 0 && F.G >= 64) ? (F.G / 8 * GEMM2_SHARE / 32) * 8 : F.G;
        const int NG4 = (F.G % 8 == 0 && F.G >= 64) ? (F.G / 8 * GEMM4_SHARE / 32) * 8 : F.G;
        if ((int)blockIdx.x < NG4) {
            pg8::Gemm g{A.Y(), A.WOUT(), NTOK, DM, DM}; pg8::StaticOrder S; S.init(NTOK, DM, NG4, (int)blockIdx.x);
            EpiStoreFrag E{A.O(), DM / 256};
            pg8::gemm_phase<EpiStoreFrag, pg8::StaticOrder, true, true>(F.lds + RING_OFF, g, S, E, F.wave);
            if (threadIdx.x == 0) __hip_atomic_fetch_add(A.ctl() + CW_DONE, 1u, RLX_AGENT);
        }
        expert_worker(phase_frame(F), A, (unsigned)(NG2 + NG4)); }
    if (REPS(4) == 2) {   pg8::Gemm g{A.Y(), A.WOUT(), NTOK, DM, DM}; pg8::StaticOrder S; S.init(NTOK, DM, F.G, (int)blockIdx.x);
        EpiStoreFrag E{A.O(), DM / 256};
        pg8::gemm_phase<EpiStoreFrag, pg8::StaticOrder, true, true>(F.lds + RING_OFF, g, S, E, F.wave); }
#endif
    xcd_barrier(bar, F.wave);
#if PHMASK & 32
    p5_norm2_router(phase_frame(F), A);
    __syncthreads();
    TL_AT(11, tl_acc -= TL_NOW());
    expert_worker(phase_frame(F), A, 0u);
    TL_AT(11, tl_acc += TL_NOW());
#endif
    xcd_barrier(bar, F.wave);
    moe_tables(phase_frame(F), A);
    MoeSched MS; MS.T = (const LAS int*)(F.lds + TAB_OFF);
#if PHMASK & 64
#ifdef REP6LOOP
    for (int rep = 0; rep < 2; ++rep)
#endif
    {   EpiGateUp8 E{A.HID()};
        gemm_phase_moe8<EpiGateUp8, true>(F.lds + RING_OFF, A.H8(), A.WGU(), DM, A.lista(), MS, E, F.wave); }
#endif
    xcd_barrier(bar, F.wave);
#if PHMASK & 128
#ifdef REP7LOOP
    for (int rep = 0; rep < 2; ++rep)
#endif
    {   EpiDown8 E{A.YD(), A.lista()};
        gemm_phase_moe8<EpiDown8, false>(F.lds + RING_OFF, A.HID(), A.WD(), DEXP, A.lista(), MS, E, F.wave); }
#endif
    xcd_barrier(bar, F.wave);
#if PHMASK & 256
    p8_final(phase_frame(F), A);
#endif
#ifdef TLSEL
    if (blockIdx.x == 0 && F.wave == 0) { const unsigned long long t0 = __builtin_amdgcn_s_memrealtime(), w = (unsigned long long)tl_acc * TLMUL;
        while (__builtin_amdgcn_s_memrealtime() - t0 < w) __builtin_amdgcn_s_sleep(8); }
#endif
}

extern "C" void kernel_launch(void* const* d_in, const int* in_sizes, int n_in, void* d_out, int out_size, void* d_ws, size_t ws_size, hipStream_t stream) {
    static int grid = 0;
    if (grid == 0) {
        if (n_in != 23 || in_sizes[0] != NTOK * DM || out_size != NTOK * DM || ws_size < WS_END) { fprintf(stderr, "kernel_launch: unexpected shapes (n_in %d, in0 %d, out %d, ws %zu)\n", n_in, n_in > 0 ? in_sizes[0] : -1, out_size, ws_size); grid = -1; return; }
        int dev = 0, cus = 0, per_cu = 0;
        if (hipGetDevice(&dev) != hipSuccess || hipDeviceGetAttribute(&cus, hipDeviceAttributeMultiprocessorCount, dev) != hipSuccess) { grid = -1; return; }
        if (hipFuncSetAttribute((const void*)mk_fwd, hipFuncAttributeMaxDynamicSharedMemorySize, LDS_BYTES) != hipSuccess) { fprintf(stderr, "kernel_launch: hipFuncSetAttribute failed\n"); grid = -1; return; }
        if (hipOccupancyMaxActiveBlocksPerMultiprocessor(&per_cu, (const void*)mk_fwd, NWAVES * 64, LDS_BYTES) != hipSuccess || per_cu < 1) { fprintf(stderr, "kernel_launch: occupancy query says %d\n", per_cu); }
        (void)hipGetLastError();
        grid = cus;
    }
    if (grid < 0) return;
    if (hipMemsetAsync((char*)d_ws + WS_CTL, 0, CTL_ZERO_BYTES, stream) != hipSuccess) return;
    Args a{};
    for (int i = 0; i < 23; ++i) a.in[i] = (const float*)d_in[i];
    a.out_ = (float*)d_out; a.ws = (unsigned char*)d_ws;
    hipLaunchKernelGGL(mk_fwd, dim3(grid), dim3(NWAVES * 64), LDS_BYTES, stream, a);
}
```

```cpp
#include <hip/hip_runtime.h>
#include <cstdio>
#include <cstdint>
#define GEMM2_SHARE 25
namespace pg8 {
#define PG8_LAS __attribute__((address_space(3)))
typedef unsigned short bf16_t;
typedef short bf16x8 __attribute__((ext_vector_type(8)));
typedef float f32x4 __attribute__((ext_vector_type(4)));
typedef unsigned u32x4 __attribute__((ext_vector_type(4)));
constexpr int BM = 256, BK = 64, HALF = 128, HTB = HALF * BK * 2  , STAGE_BYTES = 8 * HTB, NXCD = 8, WGM = 8;

__host__ __device__ __forceinline__ int lds_byte(int r, int c) { const int st = (r >> 4) * 2 + (c >> 5), rr = r & 15, cc = c & 31, ob = rr * 64 + cc * 2; return st * 1024 + (ob ^ (((ob >> 9) & 1) << 5)); }
__host__ __device__ __forceinline__ void stage_rc(int b, int& R, int& C) { const int st = b / 1024, sb = b % 1024, swz = sb ^ (((sb >> 9) & 1) << 5); R = (st >> 1) * 16 + swz / 64; C = (st & 1) * 32 + (swz % 64) / 2; }
__host__ __device__ __forceinline__ int perm32(int rho) { const int n = rho >> 4, i = rho & 15; return 8 * (i >> 2) + 4 * n + (i & 3); }

struct Unit { int pm, pn; };
struct Gemm { const bf16_t* A; const bf16_t* Bt; int M, N, K; };

struct StaticOrder {
    int nM, nN, nwg, G, c;
    __host__ __device__ void init(int M, int N, int G_, int c_) { nM = M / BM; nN = N / BM; nwg = nM * nN; G = G_; c = c_; }
    __host__ __device__ bool next(int i, Unit& u) const {
        const long L = (long)i * G + c; if (L >= nwg) return false;
        int wgid = (int)L; { const int q = nwg / NXCD, r = nwg % NXCD, xcd = wgid % NXCD, off = wgid / NXCD; wgid = (xcd < r ? xcd * (q + 1) : r * (q + 1) + (xcd - r) * q) + off; }
        const int nig = WGM * nN, gid = wgid / nig, fm = gid * WGM, gsz = (nM - fm) < WGM ? (nM - fm) : WGM;
        u.pm = fm + ((wgid % nig) % gsz); u.pn = (wgid % nig) / gsz; return true;
    }
    __device__ __forceinline__ void a_ready(const Unit&) const {}
    __device__ __forceinline__ void done(const Unit&) const {}
};

__device__ __forceinline__ unsigned cvt_pk_bf16(float lo, float hi) { unsigned r; asm volatile("v_cvt_pk_bf16_f32 %0, %1, %2" : "=v"(r) : "v"(lo), "v"(hi)); return r; }
typedef float f32x2 __attribute__((ext_vector_type(2)));
typedef float f32x2 __attribute__((ext_vector_type(2)));
template <class Epi, class Sched, bool ALIGN_EPI = false, bool SP2 = false>
__device__ __forceinline__ void gemm_phase(PG8_LAS unsigned char* lds, const Gemm g, const Sched& S, const Epi& E, const int wave_id) {
    int tid_; asm volatile("v_mbcnt_lo_u32_b32 %0, -1, 0\n\tv_mbcnt_hi_u32_b32 %0, -1, %0" : "=v"(tid_)); tid_ += wave_id * 64;
    const int tid = tid_, wid = __builtin_amdgcn_readfirstlane(tid >> 6), lane = tid & 63, wr = wid >> 2, wc = wid & 3, fr = lane & 15, fq = lane >> 4;
    const int K = g.K, nt = K / BK;
    unsigned voffA[2], voffB[2];
#pragma unroll
    for (int i = 0; i < 2; ++i) { int R, C; stage_rc(tid * 16 + i * 8192, R, C); const int Rb = Epi::PERM ? ((R & ~31) + perm32(R & 31)) : R;
        voffA[i] = (unsigned)(R * K + C) * 2u; voffB[i] = (unsigned)(Rb * K + C) * 2u; }
    const size_t kstep = (size_t)(BK * 2);
    const size_t hstep = (size_t)HALF * K * 2;
    const size_t tstep = 2 * hstep;
    const unsigned ldsw = (unsigned)wid * 1024u;
    const int aoff = lds_byte(wr * 64 + fr, fq * 8), boff = lds_byte(wc * 32 + fr, fq * 8);
#define PG8_SA(b, h) (((b) * 2 + (h)) * HTB)
#define PG8_SB(b, h) ((4 + (b) * 2 + (h)) * HTB)
#define PG8_STAGE(bufoff, gbase, voff) do { _Pragma("unroll") for (int _i = 0; _i < 2; ++_i) { const char* _gb = (const char*)(gbase); asm volatile("" : "+s"(_gb));     \
        __builtin_amdgcn_global_load_lds((const unsigned*)(_gb + (voff)[_i]), (PG8_LAS unsigned*)(lds + (bufoff) + ldsw + _i * 8192), 16, 0, 0); } } while (0)
#define PG8_LDA(dst, b, h) do { _Pragma("unroll") for (int m = 0; m < 4; ++m) _Pragma("unroll") for (int k = 0; k < 2; ++k) dst[m][k] = *(const PG8_LAS bf16x8*)(lds + PG8_SA(b, h) + aoff + m * 2048 + k * 1024); } while (0)
#define PG8_LDB(dst, b, h) do { _Pragma("unroll") for (int n = 0; n < 2; ++n) _Pragma("unroll") for (int k = 0; k < 2; ++k) dst[n][k] = *(const PG8_LAS bf16x8*)(lds + PG8_SB(b, h) + boff + n * 2048 + k * 1024); } while (0)
#define PG8_MMA(ai, bj, At, Bt) do { __builtin_amdgcn_s_setprio(1); _Pragma("unroll") for (int m = 0; m < 4; ++m) _Pragma("unroll") for (int n = 0; n < 2; ++n) _Pragma("unroll") for (int k = 0; k < 2; ++k) \
        acc[ai][bj][m][n] = __builtin_amdgcn_mfma_f32_16x16x32_bf16(Bt[n][k], At[m][k], acc[ai][bj][m][n], 0, 0, 0); __builtin_amdgcn_s_setprio(0); } while (0)
#define PG8_WAIT_V(n) asm volatile("s_waitcnt vmcnt(" #n ")" ::: "memory")
#define PG8_WAIT_L(n) asm volatile("s_waitcnt lgkmcnt(" #n ")" ::: "memory")
#define PG8_BAR __builtin_amdgcn_s_barrier()
#define PG8_SCHED __builtin_amdgcn_sched_barrier(0)
    Unit cur, nxt; int ui = 0;
    if (!S.next(0, cur)) return;
    f32x4 acc[2][2][4][2];
#pragma unroll
    for (int a = 0; a < 2; ++a)
#pragma unroll
        for (int b = 0; b < 2; ++b)
#pragma unroll
            for (int m = 0; m < 4; ++m)
#pragma unroll
                for (int n = 0; n < 2; ++n) acc[a][b][m][n] = (f32x4){0.f, 0.f, 0.f, 0.f};
    bf16x8 At[4][2], B0[2][2], B1[2][2];
    const char* cA = (const char*)g.A + (size_t)cur.pm * tstep; const char* cB = (const char*)g.Bt + (size_t)cur.pn * tstep;
    S.a_ready(cur);
    if constexpr (SP2) {
        PG8_STAGE(PG8_SB(0, 0), cB, voffB); PG8_STAGE(PG8_SB(0, 1), cB + hstep, voffB); PG8_STAGE(PG8_SA(0, 0), cA, voffA); PG8_STAGE(PG8_SA(0, 1), cA + hstep, voffA);
        if (wr == 1) PG8_BAR;
        PG8_WAIT_V(2); PG8_BAR;
        PG8_STAGE(PG8_SB(1, 0), cB + kstep, voffB); PG8_STAGE(PG8_SA(1, 0), cA + kstep, voffA); PG8_STAGE(PG8_SB(1, 1), cB + hstep + kstep, voffB);
        PG8_WAIT_V(6); PG8_BAR;
    } else {
        PG8_STAGE(PG8_SB(0, 0), cB, voffB); PG8_STAGE(PG8_SA(0, 0), cA, voffA); PG8_STAGE(PG8_SB(0, 1), cB + hstep, voffB); PG8_STAGE(PG8_SA(0, 1), cA + hstep, voffA);
        if (wr == 1) PG8_BAR;
        PG8_WAIT_V(4); PG8_BAR;
        PG8_STAGE(PG8_SB(1, 0), cB + kstep, voffB); PG8_STAGE(PG8_SA(1, 0), cA + kstep, voffA); PG8_STAGE(PG8_SB(1, 1), cB + hstep + kstep, voffB);
        PG8_WAIT_V(6); PG8_BAR;
    }
    for (;;) {
        const bool has_next = S.next(ui + 1, nxt);
        const char* nA = has_next ? (const char*)g.A + (size_t)nxt.pm * tstep : cA; const char* nB = has_next ? (const char*)g.Bt + (size_t)nxt.pn * tstep : cB;
        for (int t = 0; t < nt; t += 2) {
            const bool last = (t == nt - 2);
            const char* a1 = cA + (size_t)(t + 1) * kstep;
            const char* a2 = last ? nA : cA + (size_t)(t + 2) * kstep; const char* b2 = last ? nB : cB + (size_t)(t + 2) * kstep;
            const char* a3 = a2 + kstep; const char* b3 = b2 + kstep;
            if (last && has_next) S.a_ready(nxt);
            if constexpr (SP2) {
            PG8_LDB(B0, 0, 0); PG8_LDB(B1, 0, 1); PG8_SCHED; PG8_LDA(At, 0, 0); PG8_STAGE(PG8_SA(1, 1), a1 + hstep, voffA);
            PG8_WAIT_V(8); PG8_WAIT_L(0); PG8_BAR; PG8_MMA(0, 0, At, B0); PG8_MMA(0, 1, At, B1); PG8_BAR; PG8_SCHED;
            PG8_LDA(At, 0, 1); PG8_STAGE(PG8_SB(0, 0), b2, voffB); PG8_STAGE(PG8_SB(0, 1), b2 + hstep, voffB); PG8_STAGE(PG8_SA(0, 0), a2, voffA);
            PG8_WAIT_V(8); PG8_WAIT_L(0); PG8_BAR; PG8_MMA(1, 0, At, B0); PG8_MMA(1, 1, At, B1); PG8_BAR; PG8_SCHED;
            PG8_LDB(B0, 1, 0); PG8_LDB(B1, 1, 1); PG8_SCHED; PG8_LDA(At, 1, 0); PG8_STAGE(PG8_SA(0, 1), a2 + hstep, voffA);
            PG8_WAIT_V(8); PG8_WAIT_L(0); PG8_BAR; PG8_MMA(0, 0, At, B0); PG8_MMA(0, 1, At, B1); PG8_BAR; PG8_SCHED;
            PG8_LDA(At, 1, 1); PG8_STAGE(PG8_SB(1, 0), b3, voffB); PG8_STAGE(PG8_SB(1, 1), b3 + hstep, voffB); PG8_STAGE(PG8_SA(1, 0), a3, voffA);
            PG8_WAIT_V(8); PG8_WAIT_L(0); PG8_BAR; PG8_MMA(1, 0, At, B0); PG8_MMA(1, 1, At, B1); PG8_BAR; PG8_SCHED;
            } else {
            PG8_LDB(B0, 0, 0); PG8_SCHED; PG8_LDA(At, 0, 0); PG8_STAGE(PG8_SA(1, 1), a1 + hstep, voffA);
            PG8_WAIT_L(8); PG8_BAR; PG8_WAIT_L(0); PG8_MMA(0, 0, At, B0); PG8_BAR; PG8_SCHED;
            PG8_LDB(B1, 0, 1); PG8_STAGE(PG8_SB(0, 0), b2, voffB);
            PG8_BAR; PG8_WAIT_L(0); PG8_MMA(0, 1, At, B1); PG8_BAR;
            PG8_LDA(At, 0, 1); PG8_STAGE(PG8_SA(0, 0), a2, voffA);
            PG8_BAR; PG8_WAIT_L(0); PG8_MMA(1, 0, At, B0); PG8_BAR; PG8_SCHED;
            PG8_STAGE(PG8_SB(0, 1), b2 + hstep, voffB);
            PG8_WAIT_V(6); PG8_BAR; PG8_MMA(1, 1, At, B1); PG8_BAR;
            PG8_LDB(B0, 1, 0); PG8_SCHED; PG8_LDA(At, 1, 0); PG8_STAGE(PG8_SA(0, 1), a2 + hstep, voffA);
            PG8_WAIT_L(8); PG8_BAR; PG8_WAIT_L(0); PG8_MMA(0, 0, At, B0); PG8_BAR; PG8_SCHED;
            PG8_LDB(B1, 1, 1); PG8_STAGE(PG8_SB(1, 0), b3, voffB);
            PG8_BAR; PG8_WAIT_L(0); PG8_MMA(0, 1, At, B1); PG8_BAR;
            PG8_LDA(At, 1, 1); PG8_STAGE(PG8_SA(1, 0), a3, voffA);
            PG8_BAR; PG8_WAIT_L(0); PG8_MMA(1, 0, At, B0); PG8_BAR; PG8_SCHED;
            PG8_STAGE(PG8_SB(1, 1), b3 + hstep, voffB);
            PG8_WAIT_V(6); PG8_BAR; PG8_MMA(1, 1, At, B1); PG8_BAR;
            }
        }
        if constexpr (ALIGN_EPI) { if (wr == 0) PG8_BAR; }
        if constexpr (!Epi::AFTER_DRAIN) { E(acc, cur, wr, wc, fr, fq); S.done(cur); }
        if (!has_next) break;
#pragma unroll
        for (int a = 0; a < 2; ++a)
#pragma unroll
            for (int b = 0; b < 2; ++b)
#pragma unroll
                for (int m = 0; m < 4; ++m)
#pragma unroll
                    for (int n = 0; n < 2; ++n) acc[a][b][m][n] = (f32x4){0.f, 0.f, 0.f, 0.f};
        cur = nxt; cA = nA; cB = nB; ++ui;
        if constexpr (ALIGN_EPI) { if (wr == 1) PG8_BAR; }
    }
    PG8_WAIT_V(0);
    if constexpr (!ALIGN_EPI) { if (wr == 0) PG8_BAR; }
    PG8_BAR;
    if constexpr (Epi::AFTER_DRAIN) { E.fused(acc, cur, wr, wc, fr, fq, lds, wid, lane); S.done(cur); }
#undef PG8_SA
#undef PG8_SB
#undef PG8_STAGE
#undef PG8_LDA
#undef PG8_LDB
#undef PG8_MMA
#undef PG8_WAIT_V
#undef PG8_WAIT_L
#undef PG8_BAR
#undef PG8_SCHED
}
}

constexpr int NWAVES = 8;
constexpr int DM = 2048, SEQ = 16384, NBATCH = 2, NTOK = NBATCH * SEQ;
constexpr int DCA = 1024, DINP = 5120, NEXP = 64, DEXP = 1024, LISTCAP = 32768, NMODC = 6 * DM;
constexpr int PW = 3072;
constexpr float EPS = 1e-6f;

constexpr size_t MiB = 1u << 20;
constexpr size_t WS_CTL = 0, CTL_ZERO_BYTES = 65536;
constexpr size_t WS_MOD = 1 * MiB;
constexpr size_t WS_WIN = 2 * MiB;
constexpr size_t WS_WOUT = 22 * MiB;
constexpr size_t WS_LISTA = 30 * MiB;
constexpr size_t WS_LISTW = 38 * MiB;
constexpr size_t WS_WR = 46 * MiB;
constexpr size_t WS_WGU = 64 * MiB;
constexpr size_t WS_WD = 576 * MiB;
constexpr size_t WS_H = 832 * MiB;
constexpr size_t WS_P = 960 * MiB;
constexpr size_t WS_Y = 1152 * MiB;
constexpr size_t WS_O = 1280 * MiB;
constexpr size_t WS_X1 = 1410 * MiB;
constexpr size_t WS_END = 1538 * MiB;
constexpr int CW_TMO = 0, CW_Q = 64, CW_DONE = 128, CW_BAR = 4096, CW_CNT = 8192;

constexpr int RING_OFF = 0, RING_BYTES = 131072;
constexpr int LDSCTL_OFF = 143360;
constexpr int TAB_OFF = LDSCTL_OFF + 1024;
constexpr int LDS_BYTES = 147456;

#define GAS __attribute__((address_space(1)))
#define LAS __attribute__((address_space(3)))
typedef unsigned short bf16;
typedef unsigned v4u __attribute__((ext_vector_type(4)));
typedef unsigned v2u __attribute__((ext_vector_type(2)));
using pg8::f32x4; using pg8::f32x2; using pg8::bf16x8;
typedef GAS unsigned gu32;
#define RLX_AGENT __ATOMIC_RELAXED, __HIP_MEMORY_SCOPE_AGENT
#define LDS_WAIT() asm volatile("s_waitcnt lgkmcnt(0)" ::: "memory")
__device__ __forceinline__ unsigned f2bf(float f) { unsigned u = __builtin_bit_cast(unsigned, f); return (u + 0x7fffu + ((u >> 16) & 1u)) >> 16; }
__device__ __forceinline__ unsigned pk2(float lo, float hi) { return f2bf(lo) | (f2bf(hi) << 16); }
__device__ __forceinline__ float bf_lo(unsigned u) { return __builtin_bit_cast(float, u << 16); }
__device__ __forceinline__ float bf_hi(unsigned u) { return __builtin_bit_cast(float, u & 0xffff0000u); }
__device__ __forceinline__ float wave_sum(float v) {
#pragma unroll
    for (int o = 1; o < 64; o <<= 1) v += __shfl_xor(v, o);
    return v;
}
constexpr float SC_H = 16.0f, SC_WGU = 64.0f, SC_HID = 8.0f, SC_WD = 32.0f;
__device__ __forceinline__ unsigned pk4_fp8(float a, float b, float c, float d) {
    a = __builtin_fminf(__builtin_fmaxf(a, -448.0f), 448.0f); b = __builtin_fminf(__builtin_fmaxf(b, -448.0f), 448.0f);
    c = __builtin_fminf(__builtin_fmaxf(c, -448.0f), 448.0f); d = __builtin_fminf(__builtin_fmaxf(d, -448.0f), 448.0f);
    int w = __builtin_amdgcn_cvt_pk_fp8_f32(a, b, 0, false); w = __builtin_amdgcn_cvt_pk_fp8_f32(c, d, w, true); return (unsigned)w; }
#define DPP_STEP(v, ctrl) ((v) + __builtin_bit_cast(float, __builtin_amdgcn_update_dpp(0, __builtin_bit_cast(int, (v)), (ctrl), 0xF, 0xF, true)))
__device__ __forceinline__ float wave_sum_dpp(float v) {
    v = DPP_STEP(v, 0xB1);
    v = DPP_STEP(v, 0x4E);
    v = DPP_STEP(v, 0x141);
    v = DPP_STEP(v, 0x140);
    const int iv = __builtin_bit_cast(int, v);
    const float r0 = __builtin_bit_cast(float, __builtin_amdgcn_readlane(iv, 0)), r1 = __builtin_bit_cast(float, __builtin_amdgcn_readlane(iv, 16));
    const float r2 = __builtin_bit_cast(float, __builtin_amdgcn_readlane(iv, 32)), r3 = __builtin_bit_cast(float, __builtin_amdgcn_readlane(iv, 48));
    return (r0 + r1) + (r2 + r3);
}
__device__ __forceinline__ void wave_sum3_dpp(float& a, float& b, float& c) {
    a = DPP_STEP(a, 0xB1); b = DPP_STEP(b, 0xB1); c = DPP_STEP(c, 0xB1);
    a = DPP_STEP(a, 0x4E); b = DPP_STEP(b, 0x4E); c = DPP_STEP(c, 0x4E);
    a = DPP_STEP(a, 0x141); b = DPP_STEP(b, 0x141); c = DPP_STEP(c, 0x141);
    a = DPP_STEP(a, 0x140); b = DPP_STEP(b, 0x140); c = DPP_STEP(c, 0x140);
    const int ia = __builtin_bit_cast(int, a), ib = __builtin_bit_cast(int, b), ic = __builtin_bit_cast(int, c);
#define RL_(v, l) __builtin_bit_cast(float, __builtin_amdgcn_readlane((v), (l)))
    a = (RL_(ia, 0) + RL_(ia, 16)) + (RL_(ia, 32) + RL_(ia, 48));
    b = (RL_(ib, 0) + RL_(ib, 16)) + (RL_(ib, 32) + RL_(ib, 48));
    c = (RL_(ic, 0) + RL_(ic, 16)) + (RL_(ic, 32) + RL_(ic, 48));
#undef RL_
}
typedef _Float16 f16x2_ __attribute__((ext_vector_type(2)));
typedef _Float16 f16x8_ __attribute__((ext_vector_type(8)));
__device__ __forceinline__ unsigned pkh2(float lo, float hi) { const f16x2_ h = {(_Float16)lo, (_Float16)hi}; return __builtin_bit_cast(unsigned, h); }
__device__ __forceinline__ float h_lo(unsigned u) { return (float)__builtin_bit_cast(f16x2_, u).x; }
__device__ __forceinline__ float h_hi(unsigned u) { return (float)__builtin_bit_cast(f16x2_, u).y; }
__device__ __forceinline__ unsigned cvt2bf(float lo, float hi) { unsigned r; asm volatile("v_cvt_pk_bf16_f32 %0, %1, %2" : "=v"(r) : "v"(lo), "v"(hi)); return r; }
__device__ __forceinline__ float dot4(f32x4 a, f32x4 b) { return (a.x * b.x + a.y * b.y) + (a.z * b.z + a.w * b.w); }

__device__ __forceinline__ int lane_id_fresh() { int l; asm volatile("v_mbcnt_lo_u32_b32 %0, -1, 0\n\tv_mbcnt_hi_u32_b32 %0, -1, %0" : "=v"(l)); return l; }
#define XB_TMO      128
#define XB_XCNT(j)  (256  + 64 * (j))
#define XB_XSUB(j)  (1280 + 64 * (j))
#define XB_XGEN(j)  (2304 + 64 * (j))
#define XB_TOP      3328
#define XB_TOPGEN   3392
#define XCD_BAR_WORDS 3456
#define XB_SPIN_CAP (1u << 22)

__device__ __forceinline__ unsigned xb_ld(unsigned* p)              { return __hip_atomic_load(p, __ATOMIC_RELAXED, __HIP_MEMORY_SCOPE_AGENT); }
__device__ __forceinline__ unsigned xb_add(unsigned* p, unsigned v) { return __hip_atomic_fetch_add(p, v, __ATOMIC_RELAXED, __HIP_MEMORY_SCOPE_AGENT); }
__device__ __forceinline__ unsigned xb_xcc_id() { return (unsigned)__builtin_amdgcn_s_getreg((3 << 11) | 20) & 0xFu; }
#define XB_SPIN(cond, bar) do { unsigned _sp = 0; while (cond) { __builtin_amdgcn_s_sleep(1); \
    if ((++_sp & 255u) == 0u) { if (xb_ld(&(bar)[XB_TMO])) break; if (_sp > XB_SPIN_CAP) { atomicAdd(&(bar)[XB_TMO], 1u); break; } } } } while (0)

struct XcdBarrier { unsigned* bar; unsigned x; volatile LAS unsigned* st; };

__device__ __forceinline__ XcdBarrier xcd_barrier_post(unsigned* bar, volatile LAS unsigned* st) {
    XcdBarrier b; b.bar = bar; b.x = xb_xcc_id(); b.st = st;
    if (threadIdx.x == 0) (void)xb_add(&bar[XB_XCNT(b.x)], 1u);
    return b;
}
__device__ __forceinline__ void xcd_barrier_complete(unsigned* bar, unsigned x, unsigned& nloc, unsigned& nx) {
    const unsigned G = gridDim.x * gridDim.y * gridDim.z;
    unsigned sum, cnt, mine, sp = 0u;
    for (;;) {
        sum = 0u; cnt = 0u; mine = 0u;
#pragma unroll
        for (unsigned j = 0; j < 16; ++j) { const unsigned c = xb_ld(&bar[XB_XCNT(j)]); sum += c; cnt += (c > 0u) ? 1u : 0u; mine = (j == x) ? c : mine; }
        if (sum == G) break;
        __builtin_amdgcn_s_sleep(1);
        if ((++sp & 255u) == 0u) { if (xb_ld(&bar[XB_TMO])) break; if (sp > XB_SPIN_CAP) { atomicAdd(&bar[XB_TMO], 1u); break; } }
    }
    nloc = mine > 0u ? mine : 1u; nx = cnt > 0u ? cnt : 1u;
}
__device__ __forceinline__ void xcd_barrier(const XcdBarrier& b, const int wave_id) {
    asm volatile("s_waitcnt vmcnt(0)" ::: "memory");
    __syncthreads();
    if (wave_id == 0 && lane_id_fresh() == 0) {
        unsigned* bar = b.bar; asm volatile("" : "+s"(bar));
        __builtin_amdgcn_s_waitcnt(0);
        unsigned nloc = b.st[0], nx = b.st[1];
        if (nloc == 0u) { xcd_barrier_complete(bar, b.x, nloc, nx); b.st[0] = nloc; b.st[1] = nx; }
        const unsigned old = xb_add(&bar[XB_XSUB(b.x)], 1u);
        const unsigned gen = old / nloc;
        if (old + 1u == (gen + 1u) * nloc) {
            __builtin_amdgcn_fence(__ATOMIC_RELEASE, "agent");
            asm volatile("s_waitcnt vmcnt(0)" ::: "memory");
            const unsigned og = xb_add(&bar[XB_TOP], 1u);
            const unsigned tg = og / nx;
            if (og + 1u == (tg + 1u) * nx) xb_add(&bar[XB_TOPGEN], 1u);
            else XB_SPIN(xb_ld(&bar[XB_TOPGEN]) == tg, bar);
            __builtin_amdgcn_fence(__ATOMIC_ACQUIRE, "agent");
            xb_add(&bar[XB_XGEN(b.x)], 1u);
            asm volatile("s_waitcnt vmcnt(0)" ::: "memory");
        } else {
            XB_SPIN(xb_ld(&bar[XB_XGEN(b.x)]) == gen, bar);
            __builtin_amdgcn_fence(__ATOMIC_ACQUIRE, "agent");
            asm volatile("s_waitcnt vmcnt(0)" ::: "memory");
        }
    }
    __syncthreads();
}

struct Args {
    const float* in[23]; float* out_; unsigned char* ws;
#define ARGS_IN(name, k) __device__ __forceinline__ const float* name() const { return in[k]; }
    ARGS_IN(x, 0) ARGS_IN(c, 1) ARGS_IN(w_ada, 2) ARGS_IN(b_ada, 3) ARGS_IN(g_pre1, 4) ARGS_IN(g_post1, 5) ARGS_IN(w_in, 6) ARGS_IN(conv_a, 7) ARGS_IN(norm_a, 8)
    ARGS_IN(conv_b, 9) ARGS_IN(conv_b_bias, 10) ARGS_IN(ln_g, 11) ARGS_IN(ln_b, 12) ARGS_IN(w_out, 13) ARGS_IN(g_pre2, 14) ARGS_IN(g_post2, 15) ARGS_IN(w_rg, 16)
    ARGS_IN(b_rg, 17) ARGS_IN(w_re, 18) ARGS_IN(b_re, 19) ARGS_IN(w_eg, 20) ARGS_IN(w_eu, 21) ARGS_IN(w_ed, 22)
#undef ARGS_IN
    __device__ __forceinline__ float* out() const { return out_; }
    __device__ __forceinline__ unsigned* ctl() const { return (unsigned*)(ws + WS_CTL); }
    __device__ __forceinline__ float* mod() const { return (float*)(ws + WS_MOD); }
    __device__ __forceinline__ bf16* WIN() const { return (bf16*)(ws + WS_WIN); }
    __device__ __forceinline__ bf16* WOUT() const { return (bf16*)(ws + WS_WOUT); }
    __device__ __forceinline__ unsigned char* WGU() const { return ws + WS_WGU; }
    __device__ __forceinline__ unsigned char* WD() const { return ws + WS_WD; }
    __device__ __forceinline__ bf16* H() const { return (bf16*)(ws + WS_H); }
    __device__ __forceinline__ bf16* P() const { return (bf16*)(ws + WS_P); }
    __device__ __forceinline__ bf16* Y() const { return (bf16*)(ws + WS_Y); }
    __device__ __forceinline__ bf16* O() const { return (bf16*)(ws + WS_O); }
    __device__ __forceinline__ unsigned char* HID() const { return ws + WS_P; }
    __device__ __forceinline__ unsigned char* H8() const { return ws + WS_H; }
    __device__ __forceinline__ bf16* YD() const { return (bf16*)(ws + WS_Y); }
    __device__ __forceinline__ int* lista() const { return (int*)(ws + WS_LISTA); }
    __device__ __forceinline__ float* listw() const { return (float*)(ws + WS_LISTW); }
    __device__ __forceinline__ bf16* WR() const { return (bf16*)(ws + WS_WR); }
    __device__ __forceinline__ bf16* X1() const { return (bf16*)(ws + WS_X1); }
};
struct Frame { LAS unsigned char* lds; int tid, lane, wave, vcu, G; };
__device__ __forceinline__ Frame phase_frame(const Frame& F0) { Frame F = F0; const int l = lane_id_fresh(); F.lane = l; F.tid = F0.wave * 64 + l; return F; }

__device__ __forceinline__ void p0_ada(const Frame& F, const Args& A) {
    if ((int)blockIdx.x >= 192) return;
    LAS float* sc = (LAS float*)(F.lds + RING_OFF);
    LAS float* red = (LAS float*)(F.lds + RING_OFF + 16384);
    for (int i = F.tid; i < 2 * DM; i += NWAVES * 64) { const int b = i >> 11, k = i & (DM - 1); const float cv = A.c()[b * DM + k]; sc[k * 2 + b] = cv / (1.0f + expf(-cv)); }
    __syncthreads();
    for (int it = blockIdx.x; it < 192; it += F.G) {
        const int k0 = F.wave * 256;
        const float* wp = A.w_ada() + (size_t)k0 * NMODC + it * 64 + F.lane;
        float a0 = 0.f, a1 = 0.f;
        for (int kk = 0; kk < 256; kk += 64) {
            float wv[64];
#pragma unroll
            for (int k = 0; k < 64; ++k) wv[k] = wp[(size_t)(kk + k) * NMODC];
#pragma unroll
            for (int k = 0; k < 64; ++k) { const f32x2 s = *(const LAS f32x2*)(sc + (k0 + kk + k) * 2); a0 += s.x * wv[k]; a1 += s.y * wv[k]; }
        }
        red[(F.wave * 2 + 0) * 64 + F.lane] = a0; red[(F.wave * 2 + 1) * 64 + F.lane] = a1;
        __syncthreads();
        if (F.tid < 128) { const int b = F.tid >> 6, l = F.tid & 63; float s = 0.f;
#pragma unroll
            for (int w = 0; w < 8; ++w) s += red[(w * 2 + b) * 64 + l];
            A.mod()[b * NMODC + it * 64 + l] = s + A.b_ada()[it * 64 + l]; }
        __syncthreads();
    }
}
__host__ __device__ __forceinline__ int inproj_row(int n0) {
    if (n0 < 1024) return n0;
    const int seg = (n0 - 1024) >> 10, off = (n0 - 1024) & 1023, j = off >> 7, r = off & 127;
    return (seg < 2 ? 1024 : 3072) + 256 * j + 128 * (seg & 1) + r;
}
__device__ __forceinline__ void transpose_item_bf16(const float* W, int N, int k0, int n0, bf16* dst, int ldk, LAS float* scr, int lane) {
    float tv[32];
    { const float* wp = W + (size_t)(k0 + (lane >> 5)) * N + n0 + (lane & 31);
#pragma unroll
      for (int i = 0; i < 32; ++i) tv[i] = wp[(size_t)(2 * i) * N]; }
#pragma unroll
    for (int i = 0; i < 32; ++i) scr[(2 * i + (lane >> 5)) * 33 + (lane & 31)] = tv[i];
    LDS_WAIT(); asm volatile("" ::: "memory");
    const int c = lane & 7;
#pragma unroll
    for (int j = 0; j < 4; ++j) { const int n = (lane >> 3) + 8 * j; const LAS float* sp = scr + (8 * c) * 33 + n;
        v4u o; o.x = pk2(sp[0 * 33], sp[1 * 33]); o.y = pk2(sp[2 * 33], sp[3 * 33]); o.z = pk2(sp[4 * 33], sp[5 * 33]); o.w = pk2(sp[6 * 33], sp[7 * 33]);
        *(v4u*)(dst + (size_t)n * ldk + 8 * c) = o; }
    LDS_WAIT(); asm volatile("" ::: "memory");
}
__device__ __forceinline__ void p0_router_weights(const Frame& F, const Args& A) {
    const int gt = F.vcu * NWAVES * 64 + F.tid, NGT = F.G * NWAVES * 64;
    for (int it = gt; it < 8 * 8 * 5 * 64; it += NGT) {
        const int l = it & 63, nf = (it >> 6) % 5, wc = it / 320, c = wc & 7, w = wc >> 3;
        const int n = 16 * nf + (l & 15), kg = l >> 4;
        float v[8];
#pragma unroll
        for (int j = 0; j < 8; ++j) { const int k = 256 * w + 64 * (c >> 1) + 16 * kg + 8 * (c & 1) + j;
            v[j] = n < 8 ? A.w_rg()[k * 8 + n] : (n < 72 ? A.w_re()[((size_t)((n - 8) >> 3) * DM + k) * 8 + ((n - 8) & 7)] : 0.f); }
        v4u* dst = (v4u*)A.WR() + (size_t)((w * 8 + c) * 5 + nf) * 64 + l;
        dst[0] = (v4u){pkh2(v[0], v[1]), pkh2(v[2], v[3]), pkh2(v[4], v[5]), pkh2(v[6], v[7])};
    }
}
constexpr int P0X_ITEMS = 3 * NEXP * 64;
struct XItem { const float* src; unsigned char* dst; int N; float scale; };
__device__ __forceinline__ XItem p0x_item(const Args& A, int it, int w) {
    XItem t; const int mat = it / (NEXP * 64), r = it - mat * (NEXP * 64), e = r >> 6, rr = r & 63;
    if (mat < 2) { const int kt = rr >> 2, nb = rr & 3; t.N = DEXP; t.scale = SC_WGU;
        t.src = (mat ? A.w_eu() : A.w_eg()) + (size_t)e * DM * DEXP + (size_t)(128 * kt) * DEXP + 256 * nb;
        const int nn = 32 * w, drow = 256 * (2 * nb + (nn >> 7)) + 128 * mat + (nn & 127);
        t.dst = A.WGU() + ((size_t)(e * 16 + kt) * 2048 + drow) * 128; }
    else { const int kt = rr >> 3, nb = rr & 7; t.N = DM; t.scale = SC_WD;
        t.src = A.w_ed() + (size_t)e * DEXP * DM + (size_t)(128 * kt) * DM + 256 * nb;
        t.dst = A.WD() + ((size_t)(e * 8 + kt) * 2048 + 256 * nb + 32 * w) * 128; }
    return t;
}
__device__ __forceinline__ void p0x_load(const XItem& t, int w, int lane, f32x4 (&v)[16]) {
    const f32x4* p = (const f32x4*)(t.src + (size_t)(16 * w) * t.N) + lane;
#pragma unroll
    for (int j = 0; j < 16; ++j) v[j] = __builtin_nontemporal_load((const f32x4*)((const float*)p + (size_t)j * t.N));
}
#define XW_BAR() do { LDS_WAIT(); __builtin_amdgcn_s_barrier(); asm volatile("" ::: "memory"); } while (0)
__device__ __forceinline__ void xw_put(LAS float* tile, int w, int lane, const f32x4 (&v)[16]) {
#pragma unroll
    for (int j = 0; j < 16; ++j) *(LAS f32x4*)(tile + (16 * w + j) * 260 + 4 * lane) = v[j];
}
__device__ __forceinline__ void xw_emit(const LAS float* tile, const XItem& cur, int w, int lane) {
    const int n = lane & 31, kh = lane >> 5; const float sc = cur.scale;
    const LAS float* col = tile + 32 * w + n;
#pragma unroll
    for (int q = 0; q < 4; ++q) { const LAS float* sp = col + (32 * q + 16 * kh) * 260;
        v4u o;
        o.x = pk4_fp8(sp[0 * 260] * sc, sp[1 * 260] * sc, sp[2 * 260] * sc, sp[3 * 260] * sc);     o.y = pk4_fp8(sp[4 * 260] * sc, sp[5 * 260] * sc, sp[6 * 260] * sc, sp[7 * 260] * sc);
        o.z = pk4_fp8(sp[8 * 260] * sc, sp[9 * 260] * sc, sp[10 * 260] * sc, sp[11 * 260] * sc);   o.w = pk4_fp8(sp[12 * 260] * sc, sp[13 * 260] * sc, sp[14 * 260] * sc, sp[15 * 260] * sc);
        *(v4u*)(cur.dst + (size_t)n * 128 + 32 * q + 16 * kh) = o; }
}
__device__ __forceinline__ void xw_put8(LAS unsigned* tile, int w, int lane, const f32x4 (&v)[16], float sc) {
#pragma unroll
    for (int j = 0; j < 16; ++j) tile[(16 * w + j) * 65 + lane] = pk4_fp8(v[j].x * sc, v[j].y * sc, v[j].z * sc, v[j].w * sc);
}
__device__ __forceinline__ void xw_emit8(const LAS unsigned* tile, unsigned char* dst, int w, int lane) {
    const int g = lane & 7, kc = lane >> 3;
    const LAS unsigned* col = tile + (16 * kc) * 65 + 8 * w + g;
    unsigned o[4][4];
#pragma unroll
    for (int b4 = 0; b4 < 4; ++b4) { const unsigned d0 = col[(4 * b4 + 0) * 65], d1 = col[(4 * b4 + 1) * 65], d2 = col[(4 * b4 + 2) * 65], d3 = col[(4 * b4 + 3) * 65];
        const unsigned t01l = __builtin_amdgcn_perm(d1, d0, 0x05010400u), t01h = __builtin_amdgcn_perm(d1, d0, 0x07030602u);
        const unsigned t23l = __builtin_amdgcn_perm(d3, d2, 0x05010400u), t23h = __builtin_amdgcn_perm(d3, d2, 0x07030602u);
        o[0][b4] = __builtin_amdgcn_perm(t23l, t01l, 0x05040100u); o[1][b4] = __builtin_amdgcn_perm(t23l, t01l, 0x07060302u);
        o[2][b4] = __builtin_amdgcn_perm(t23h, t01h, 0x05040100u); o[3][b4] = __builtin_amdgcn_perm(t23h, t01h, 0x07060302u); }
#pragma unroll
    for (int j = 0; j < 4; ++j) *(v4u*)(dst + (size_t)(4 * g + j) * 128 + 16 * kc) = (v4u){o[j][0], o[j][1], o[j][2], o[j][3]};
}
template <class T> __device__ __forceinline__ T* uniform_ptr(T* p) {
    const unsigned long long v = (unsigned long long)p; const unsigned lo = (unsigned)__builtin_amdgcn_readfirstlane((int)(unsigned)v), hi = (unsigned)__builtin_amdgcn_readfirstlane((int)(unsigned)(v >> 32));
    return (T*)(((unsigned long long)hi << 32) | lo);
}
__device__ __forceinline__ void xq_issue(const unsigned* ctl, unsigned& cl, unsigned& sv) {
    asm volatile("s_nop 4\n\tglobal_atomic_add %0, %2, %3, %4 offset:256 sc0\n\tglobal_load_dword %1, %2, %4 offset:512 sc1" : "=&v"(cl), "=&v"(sv) : "v"(0u), "v"(1u), "s"(ctl) : "memory");
}
static_assert(CW_Q * 4 == 256 && CW_DONE * 4 == 512, "xq_issue hard-codes the byte offsets of the queue and stop words");
__device__ __forceinline__ void expert_worker(const Frame& F, const Args& A, const unsigned stop_target) {
    LAS unsigned* tile0 = (LAS unsigned*)(F.lds + RING_OFF); LAS unsigned* tile1 = tile0 + 128 * 65; LAS unsigned* tile2 = tile1 + 128 * 65;
    volatile LAS int* qs = (volatile LAS int*)(F.lds + LDSCTL_OFF + 64);
    const int w = F.wave, lane = F.lane;
    const unsigned* ctl = uniform_ptr(A.ctl());
    if (F.tid == 0) {
        const bool stop = stop_target != 0u && __hip_atomic_load(ctl + CW_DONE, RLX_AGENT) >= stop_target;
        const int base = stop ? P0X_ITEMS : (int)__hip_atomic_fetch_add(A.ctl() + CW_Q, 4u, RLX_AGENT);
        qs[0] = base; qs[1] = base + 1; qs[2] = base + 2; qs[3] = base + 3; }
    __syncthreads();
    int i0 = qs[0], i1 = qs[1], i2 = qs[2], i3 = qs[3];
    if (i0 >= P0X_ITEMS) return;
    unsigned cl = 0u, sv = 0u; bool pend = (F.wave == 0) && i3 < P0X_ITEMS, stopped = false;
    if (pend && lane == 0) xq_issue(ctl, cl, sv);
    XItem c0 = p0x_item(A, i0, w), c1 = p0x_item(A, i1 < P0X_ITEMS ? i1 : i0, w), c2 = p0x_item(A, i2 < P0X_ITEMS ? i2 : i0, w); f32x4 va[16], vb[16], vc[16];
    p0x_load(c0, w, lane, va); p0x_load(c1, w, lane, vb); p0x_load(c2, w, lane, vc);
#define XW_CLAIM(slot) do { if (F.wave == 0) { int _n = P0X_ITEMS; \
        if (pend) { asm volatile("s_waitcnt vmcnt(16)" ::: "memory"); asm volatile("" : "+v"(cl), "+v"(sv)); _n = __builtin_amdgcn_readfirstlane((int)cl); \
            if (stop_target != 0u && (unsigned)__builtin_amdgcn_readfirstlane((int)sv) >= stop_target) stopped = true; } \
        if (lane == 0) qs[slot] = _n; \
        pend = !stopped && _n < P0X_ITEMS; \
        if (pend && lane == 0) xq_issue(ctl, cl, sv); } } while (0)
    for (;;) {
        xw_put8(tile0, w, lane, va, c0.scale);
        XW_CLAIM(0);
        XW_BAR();
        const XItem cA = p0x_item(A, i3 < P0X_ITEMS ? i3 : i0, w);
        p0x_load(cA, w, lane, va);
        xw_emit8(tile0, c0.dst, w, lane);
        if (i1 >= P0X_ITEMS) break;
        const int n0 = qs[0];
        xw_put8(tile1, w, lane, vb, c1.scale);
        XW_CLAIM(1);
        XW_BAR();
        const XItem cB = p0x_item(A, n0 < P0X_ITEMS ? n0 : i1, w);
        p0x_load(cB, w, lane, vb);
        xw_emit8(tile1, c1.dst, w, lane);
        if (i2 >= P0X_ITEMS) break;
        const int n1 = qs[1];
        xw_put8(tile2, w, lane, vc, c2.scale);
        XW_CLAIM(2);
        XW_BAR();
        const XItem cC = p0x_item(A, n1 < P0X_ITEMS ? n1 : i2, w);
        p0x_load(cC, w, lane, vc);
        xw_emit8(tile2, c2.dst, w, lane);
        if (i3 >= P0X_ITEMS) break;
        i0 = i3; c0 = cA; i1 = n0; c1 = cB; i2 = n1; c2 = cC; i3 = qs[2];
    }
    XW_BAR();
#undef XW_CLAIM
}
__device__ __forceinline__ void p0_weights(const Frame& F, const Args& A) {
    LAS float* scr = (LAS float*)(F.lds + RING_OFF + F.wave * 16896);
    const int gw = F.vcu * NWAVES + F.wave, NGW = F.G * NWAVES;
    constexpr int I_IN = 32 * 160, I_OUT = 32 * 64;
    for (int it = gw; it < I_IN + I_OUT; it += NGW) {
        if (it < I_IN) { const int kb = it / 160, nb = it % 160, n0 = 32 * nb; transpose_item_bf16(A.w_in(), DINP, 64 * kb, n0, A.WIN() + (size_t)inproj_row(n0) * DM + 64 * kb, DM, scr, F.lane); }
        else { const int r = it - I_IN, kb = r / 64, nb = r % 64, n0 = 32 * nb; transpose_item_bf16(A.w_out(), DM, 64 * kb, n0, A.WOUT() + (size_t)n0 * DM + 64 * kb, DM, scr, F.lane); }
    }
}

__device__ __forceinline__ void p1_norm1(const Frame& F, const Args& A) {
    const int gw = F.vcu * NWAVES + F.wave, NGW = F.G * NWAVES;
    f32x4 a1[8], sh[8]; int bcur = -1;
    for (int m0 = gw; m0 < NTOK; m0 += 2 * NGW) {
        const int m1 = m0 + NGW; const bool has1 = (m1 < NTOK) && ((m1 >> 14) == (m0 >> 14));
        const f32x4* xr0 = (const f32x4*)(A.x() + (size_t)m0 * DM) + 2 * F.lane;
        const f32x4* xr1 = (const f32x4*)(A.x() + (size_t)(has1 ? m1 : m0) * DM) + 2 * F.lane;
        f32x4 v0[8], v1[8];
#pragma unroll
        for (int j = 0; j < 4; ++j) { v0[2 * j] = xr0[128 * j]; v0[2 * j + 1] = xr0[128 * j + 1]; v1[2 * j] = xr1[128 * j]; v1[2 * j + 1] = xr1[128 * j + 1]; }
        if ((m0 >> 14) != bcur) { bcur = m0 >> 14;
            const f32x4* g = (const f32x4*)A.g_pre1() + 2 * F.lane; const f32x4* shp = (const f32x4*)(A.mod() + bcur * NMODC) + 2 * F.lane; const f32x4* scp = (const f32x4*)(A.mod() + bcur * NMODC + DM) + 2 * F.lane;
#pragma unroll
            for (int j = 0; j < 4; ++j) { a1[2 * j] = g[128 * j] * (scp[128 * j] + 1.0f); a1[2 * j + 1] = g[128 * j + 1] * (scp[128 * j + 1] + 1.0f); sh[2 * j] = shp[128 * j]; sh[2 * j + 1] = shp[128 * j + 1]; } }
        float s0 = 0.f, s1 = 0.f;
#pragma unroll
        for (int j = 0; j < 8; ++j) { s0 += dot4(v0[j], v0[j]); s1 += dot4(v1[j], v1[j]); }
        const float r0 = 1.0f / sqrtf(wave_sum(s0) * (1.0f / DM) + EPS), r1 = 1.0f / sqrtf(wave_sum(s1) * (1.0f / DM) + EPS);
        { v4u* o16 = (v4u*)(A.H() + (size_t)m0 * DM) + F.lane;
#pragma unroll
          for (int j = 0; j < 4; ++j) { const f32x4 ha = v0[2 * j] * r0 * a1[2 * j] + sh[2 * j], hb = v0[2 * j + 1] * r0 * a1[2 * j + 1] + sh[2 * j + 1];
              o16[64 * j] = (v4u){pg8::cvt_pk_bf16(ha.x, ha.y), pg8::cvt_pk_bf16(ha.z, ha.w), pg8::cvt_pk_bf16(hb.x, hb.y), pg8::cvt_pk_bf16(hb.z, hb.w)}; } }
        if (has1) { v4u* o16 = (v4u*)(A.H() + (size_t)m1 * DM) + F.lane;
#pragma unroll
          for (int j = 0; j < 4; ++j) { const f32x4 ha = v1[2 * j] * r1 * a1[2 * j] + sh[2 * j], hb = v1[2 * j + 1] * r1 * a1[2 * j + 1] + sh[2 * j + 1];
              o16[64 * j] = (v4u){pg8::cvt_pk_bf16(ha.x, ha.y), pg8::cvt_pk_bf16(ha.z, ha.w), pg8::cvt_pk_bf16(hb.x, hb.y), pg8::cvt_pk_bf16(hb.z, hb.w)}; } }
        else if (m1 < NTOK) { m0 -= NGW; }
    }
}

__device__ __forceinline__ float sigmoidf_(float v) { return __builtin_amdgcn_rcpf(1.0f + __expf(-v)); }
constexpr size_t OTILE_PITCH = 65536 + 128;
struct EpiStoreFrag {
    static constexpr bool PERM = true, AFTER_DRAIN = false;
    bf16* O; int ntn;
    __device__ __forceinline__ void operator()(const pg8::f32x4 (&acc)[2][2][4][2], const pg8::Unit& u, int wr, int wc, int fr, int fq) const {
        bf16* base = O + ((size_t)(u.pm * ntn + u.pn) * OTILE_PITCH) + (size_t)((wr * 4 + wc) * 16) * 512 + (fq * 16 + fr) * 8;
#pragma unroll
        for (int ai = 0; ai < 2; ++ai)
#pragma unroll
            for (int m = 0; m < 4; ++m)
#pragma unroll
                for (int bj = 0; bj < 2; ++bj) { const pg8::f32x4 v0 = acc[ai][bj][m][0], v1 = acc[ai][bj][m][1];
                    v4u w; w.x = pg8::cvt_pk_bf16(v0[0], v0[1]); w.y = pg8::cvt_pk_bf16(v0[2], v0[3]); w.z = pg8::cvt_pk_bf16(v1[0], v1[1]); w.w = pg8::cvt_pk_bf16(v1[2], v1[3]);
                    __builtin_nontemporal_store(w, (v4u*)(base + ((ai * 4 + m) * 2 + bj) * 512)); }
    }
};
struct EpiInProj {
    static constexpr bool PERM = true, AFTER_DRAIN = false;
    bf16* P;
    __device__ __forceinline__ void operator()(const pg8::f32x4 (&acc)[2][2][4][2], const pg8::Unit& u, int wr, int wc, int fr, int fq) const {
        unsigned char* pmb = (unsigned char*)P + (size_t)u.pm * 1572864; const int rowt = wr * 64 + fr;
        if (u.pn < 4) {
            unsigned char* tb = pmb + u.pn * 131072 + (wc * 32 + 8 * fq) * 2;
#pragma unroll
            for (int ai = 0; ai < 2; ++ai)
#pragma unroll
                for (int m = 0; m < 4; ++m) { unsigned char* rowp = tb + (size_t)(rowt + ai * 128 + m * 16) * 512;
#pragma unroll
                    for (int bj = 0; bj < 2; ++bj) { const pg8::f32x4 v0 = acc[ai][bj][m][0], v1 = acc[ai][bj][m][1];
                        v4u w; w.x = pg8::cvt_pk_bf16(v0[0], v0[1]); w.y = pg8::cvt_pk_bf16(v0[2], v0[3]); w.z = pg8::cvt_pk_bf16(v1[0], v1[1]); w.w = pg8::cvt_pk_bf16(v1[2], v1[3]);
                        __builtin_nontemporal_store(w, (v4u*)(rowp + bj * 256)); } }
        } else {
            const bool glu = u.pn >= 12;
            unsigned char* tb = pmb + (glu ? 1048576 + (u.pn - 12) * 65536 : 524288 + (u.pn - 4) * 65536) + (wc * 32 + 8 * fq) * 2;
#pragma unroll
            for (int ai = 0; ai < 2; ++ai)
#pragma unroll
                for (int m = 0; m < 4; ++m) { unsigned char* rowp = tb + (size_t)(rowt + ai * 128 + m * 16) * 256;
                    pg8::f32x4 a0 = acc[ai][0][m][0], a1 = acc[ai][0][m][1]; const pg8::f32x4 b0 = acc[ai][1][m][0], b1 = acc[ai][1][m][1];
                    if (glu) {
#pragma unroll
                        for (int i = 0; i < 4; ++i) { a0[i] *= sigmoidf_(b0[i]); a1[i] *= sigmoidf_(b1[i]); }
                    } else { a0 = a0 * b0; a1 = a1 * b1; }
                    v4u w; w.x = pg8::cvt_pk_bf16(a0[0], a0[1]); w.y = pg8::cvt_pk_bf16(a0[2], a0[3]); w.z = pg8::cvt_pk_bf16(a1[0], a1[1]); w.w = pg8::cvt_pk_bf16(a1[2], a1[3]);
                    __builtin_nontemporal_store(w, (v4u*)rowp); }
        }
    }
};

__device__ __forceinline__ void p3_mix(const Frame& F, const Args& A) {
    LAS float* stats = (LAS float*)(F.lds + RING_OFF);
    LAS float* fin = (LAS float*)(F.lds + RING_OFF + 4096);
    const int tid = F.tid, ch = 2 * tid;
    float ca[3][2]; f32x2 cb[31];
#pragma unroll
    for (int k = 0; k < 3; ++k) { ca[k][0] = A.conv_a()[k * DCA + ch]; ca[k][1] = A.conv_a()[k * DCA + ch + 1]; }
#pragma unroll
    for (int k = 0; k < 31; ++k) cb[k] = (f32x2){A.conv_b()[k * DCA + ch], A.conv_b()[k * DCA + ch + 1]};
    const float na0 = A.norm_a()[ch], na1 = A.norm_a()[ch + 1], bb0 = A.conv_b_bias()[ch], bb1 = A.conv_b_bias()[ch + 1];
    const float lg0 = A.ln_g()[ch], lg1 = A.ln_g()[ch + 1], lb0 = A.ln_b()[ch], lb1 = A.ln_b()[ch + 1];
    const __amdgpu_buffer_rsrc_t Prs = __builtin_amdgcn_make_buffer_rsrc((void*)A.P(), 0, (int)((size_t)NTOK * PW * 2), 0x00020000);
    const __amdgpu_buffer_rsrc_t Yrs = __builtin_amdgcn_make_buffer_rsrc((void*)A.Y(), 0, (int)((size_t)NTOK * DM * 2), 0x00020000);
    const int vo = 4 * tid;
    const int voB = (tid >> 7) * 131072 + 4 * (tid & 127), voC = 524288 + (tid >> 6) * 65536 + 4 * (tid & 63), voU = voC + 524288;
#define P3_LDB(t) __builtin_amdgcn_raw_buffer_load_b32(Prs, voB, ((t) >> 8) * 1572864 + ((t) & 255) * 512, 0)
#define P3_LDC(t) __builtin_amdgcn_raw_buffer_load_b32(Prs, voC, ((t) >> 8) * 1572864 + ((t) & 255) * 256, 0)
#define P3_LDU(t) __builtin_amdgcn_raw_buffer_load_b32(Prs, voU, ((t) >> 8) * 1572864 + ((t) & 255) * 256, 0)
#define P3_ST(v, t, cb_) __builtin_amdgcn_raw_buffer_store_b32((v), Yrs, vo, (t) * 4096 + (cb_), 0)
    for (int tile = blockIdx.x; tile < NTOK / 128; tile += F.G) {
        const int t0 = tile * 128; const bool first = (t0 & (SEQ - 1)) == 0;
        f32x2 wb[32];
        wb[0] = (f32x2){0.f, 0.f}; wb[1] = (f32x2){0.f, 0.f};
#pragma unroll
        for (int s = 2; s < 32; ++s) { unsigned uu = 0u; if (!first) uu = P3_LDU(t0 - 32 + s); wb[s] = (f32x2){bf_lo(uu), bf_hi(uu)}; }
        float cm1[2], cm2[2];
        { unsigned u1 = 0u, u2 = 0u; if (!first) { u1 = P3_LDC(t0 - 1); u2 = P3_LDC(t0 - 2); }
          cm1[0] = bf_lo(u1); cm1[1] = bf_hi(u1); cm2[0] = bf_lo(u2); cm2[1] = bf_hi(u2); }
        unsigned nb[8], nc[8], nu[8];
#pragma unroll
        for (int s = 0; s < 8; ++s) { nb[s] = P3_LDB(t0 + s); nc[s] = P3_LDC(t0 + s); nu[s] = P3_LDU(t0 + s); }
        for (int blk = 0; blk < 4; ++blk) {
#pragma unroll
            for (int sub = 0; sub < 4; ++sub) {
                const int par = sub & 1;
                const int tb = t0 + 32 * blk + 8 * sub;
                unsigned pb[8], pc[8], pu[8];
#pragma unroll
                for (int s = 0; s < 8; ++s) { pb[s] = nb[s]; pc[s] = nc[s]; pu[s] = nu[s]; }
#pragma unroll
                for (int s = 0; s < 8; ++s) { nb[s] = P3_LDB(tb + 8 + s); nc[s] = P3_LDC(tb + 8 + s); nu[s] = P3_LDU(tb + 8 + s); }
                float vk[8][2];
#pragma unroll
                for (int s = 0; s < 8; ++s) {
                    const int S = 8 * sub + s;
                    const float c0 = bf_lo(pc[s]), c1 = bf_hi(pc[s]);
                    const float ya0 = bf_lo(pb[s]) * (ca[0][0] * cm2[0] + ca[1][0] * cm1[0] + ca[2][0] * c0);
                    const float ya1 = bf_hi(pb[s]) * (ca[0][1] * cm2[1] + ca[1][1] * cm1[1] + ca[2][1] * c1);
                    cm2[0] = cm1[0]; cm2[1] = cm1[1]; cm1[0] = c0; cm1[1] = c1;
                    wb[S] = (f32x2){bf_lo(pu[s]), bf_hi(pu[s])};
                    f32x2 av = (f32x2){bb0, bb1}, aw = (f32x2){0.f, 0.f};
#pragma unroll
                    for (int k = 0; k < 30; k += 2) { av = __builtin_elementwise_fma(cb[k], wb[(S + 2 + k) & 31], av); aw = __builtin_elementwise_fma(cb[k + 1], wb[(S + 3 + k) & 31], aw); }
                    av = __builtin_elementwise_fma(cb[30], wb[S], av) + aw;
                    const float a0 = av.x, a1 = av.y;
                    vk[s][0] = a0; vk[s][1] = a1;
                    float ssa = ya0 * ya0 + ya1 * ya1, s1 = a0 + a1, s2 = a0 * a0 + a1 * a1;
                    wave_sum3_dpp(ssa, s1, s2);
                    const float ra = __builtin_amdgcn_rsqf(ssa * (1.0f / 128.0f) + EPS);
                    P3_ST(cvt2bf(ya0 * ra * na0, ya1 * ra * na1), tb + s, 0);
                    if (F.lane == 0) { stats[((par * 8 + s) * 8 + F.wave) * 2 + 0] = s1; stats[((par * 8 + s) * 8 + F.wave) * 2 + 1] = s2; }
                }
                LDS_WAIT(); __builtin_amdgcn_s_barrier(); asm volatile("" ::: "memory");
                if (tid < 8) { float q1 = 0.f, q2 = 0.f;
#pragma unroll
                    for (int w = 0; w < 8; ++w) { q1 += stats[((par * 8 + tid) * 8 + w) * 2 + 0]; q2 += stats[((par * 8 + tid) * 8 + w) * 2 + 1]; }
                    const float mean = q1 * (1.0f / 1024.0f); float var = q2 * (1.0f / 1024.0f) - mean * mean; var = var > 0.f ? var : 0.f;
                    fin[(par * 8 + tid) * 2 + 0] = mean; fin[(par * 8 + tid) * 2 + 1] = __builtin_amdgcn_rsqf(var + EPS); }
                LDS_WAIT(); __builtin_amdgcn_s_barrier(); asm volatile("" ::: "memory");
#pragma unroll
                for (int s = 0; s < 8; ++s) { const float mean = fin[(par * 8 + s) * 2 + 0], rstd = fin[(par * 8 + s) * 2 + 1];
                    const float z0 = (vk[s][0] - mean) * rstd * lg0 + lb0, z1 = (vk[s][1] - mean) * rstd * lg1 + lb1;
                    P3_ST(cvt2bf(z0 * sigmoidf_(z0), z1 * sigmoidf_(z1)), tb + s, 2048); }
            }
        }
    }
#undef P3_LDB
#undef P3_LDC
#undef P3_LDU
#undef P3_ST
}

constexpr int P5_OFF_PV = 0;
constexpr int P5_OFF_RED = 24576;
constexpr int P5_OFF_PART = 25600;
constexpr int P5_OFF_LOG = 66560;
constexpr int P5_OFF_REC = 71680;
constexpr int P5_OFF_CNT = 88064;
constexpr int P5_MAXREC = 1024;
__device__ __forceinline__ void p5_params(const Frame& F, const Args& A, int b) {
    LAS float* pv = (LAS float*)(F.lds + RING_OFF + P5_OFF_PV); const float* modb = A.mod() + b * NMODC;
    for (int k = F.tid; k < DM; k += NWAVES * 64) { pv[k] = modb[2 * DM + k] * A.g_post1()[k]; pv[DM + k] = A.g_pre2()[k] * (modb[4 * DM + k] + 1.0f); pv[2 * DM + k] = modb[3 * DM + k]; }
}
#define P5_BAR() do { LDS_WAIT(); __builtin_amdgcn_s_barrier(); asm volatile("" ::: "memory"); } while (0)
__device__ __forceinline__ void p5_norm2_router(const Frame& F, const Args& A) {
    const int lane = F.lane, w = F.wave, r = lane & 15, q = lane >> 4, kb = 256 * w, ko = kb + 16 * q;
    LAS float* pv = (LAS float*)(F.lds + RING_OFF + P5_OFF_PV);
    LAS float* red1 = (LAS float*)(F.lds + RING_OFF + P5_OFF_RED); LAS float* red2 = red1 + 128;
    LAS float* part = (LAS float*)(F.lds + RING_OFF + P5_OFF_PART);
    LAS float* lg = (LAS float*)(F.lds + RING_OFF + P5_OFF_LOG);
    LAS int* rec_e = (LAS int*)(F.lds + RING_OFF + P5_OFF_REC); LAS int* rec_a = rec_e + P5_MAXREC; LAS int* rec_p = rec_a + P5_MAXREC; LAS float* rec_w = (LAS float*)(rec_p + P5_MAXREC);
    LAS int* lcnt = (LAS int*)(F.lds + RING_OFF + P5_OFF_CNT); LAS int* lbase = lcnt + 64;
    if (F.tid < 64) lcnt[F.tid] = 0;
    const int tpb = (NTOK / 16 + F.G - 1) / F.G;
    int bcur = -1, nrec = 0;
    for (int i = 0; i < tpb; ++i) {
        const int tile = (int)blockIdx.x * tpb + i; if (tile >= NTOK / 16) break;
        const int mt0 = tile * 16, b = mt0 >> 14, m = mt0 + r;
        const float* xrow = A.x() + (size_t)m * DM + ko;
        const int oidx = (mt0 >> 4) & 15;
        const bf16* otile = A.O() + (size_t)((mt0 >> 8) * 8 + w) * OTILE_PITCH + (size_t)(((oidx >> 2) & 1) * 64 * 512) + (size_t)(((oidx >> 3) * 4 + (oidx & 3)) * 2) * 512 + (size_t)r * 8;
        f32x4 xv[4][4]; v4u ov[4][2];
#pragma unroll
        for (int cg = 0; cg < 4; ++cg) {
#pragma unroll
            for (int j = 0; j < 4; ++j) xv[cg][j] = *(const f32x4*)(xrow + 64 * cg + 4 * j);
#pragma unroll
            for (int hh = 0; hh < 2; ++hh) { const int wcq = (2 * cg + (q >> 1)) & 3, fqq = 2 * (q & 1) + hh;
                ov[cg][hh] = *(const v4u*)(otile + (size_t)(wcq * 16 + (cg >> 1)) * 512 + fqq * 128); } }
        if (b != bcur) { P5_BAR(); p5_params(F, A, b); bcur = b; P5_BAR(); }
        float so = 0.f;
#pragma unroll
        for (int cg = 0; cg < 4; ++cg)
#pragma unroll
            for (int hh = 0; hh < 2; ++hh) { const v4u p = ov[cg][hh]; const f32x4 va = (f32x4){bf_lo(p.x), bf_hi(p.x), bf_lo(p.y), bf_hi(p.y)}, vb = (f32x4){bf_lo(p.z), bf_hi(p.z), bf_lo(p.w), bf_hi(p.w)};
                so += dot4(va, va) + dot4(vb, vb); }
        so += __shfl_xor(so, 16); so += __shfl_xor(so, 32);
        if (q == 0) red1[w * 16 + r] = so;
        P5_BAR();
        float to = 0.f;
#pragma unroll
        for (int ww = 0; ww < 8; ++ww) to += red1[ww * 16 + r];
        const float ro = 1.0f / sqrtf(to * (1.0f / DM) + EPS);
        bf16* x1row = A.X1() + (size_t)m * DM + ko; float sx = 0.f;
#pragma unroll
        for (int cg = 0; cg < 4; ++cg)
#pragma unroll
            for (int hh = 0; hh < 2; ++hh) { const v4u p = ov[cg][hh]; const f32x4 va = (f32x4){bf_lo(p.x), bf_hi(p.x), bf_lo(p.y), bf_hi(p.y)}, vb = (f32x4){bf_lo(p.z), bf_hi(p.z), bf_lo(p.w), bf_hi(p.w)};
                const f32x4 a1a = *(const LAS f32x4*)(pv + ko + 64 * cg + 8 * hh), a1b = *(const LAS f32x4*)(pv + ko + 64 * cg + 8 * hh + 4);
                const f32x4 x1a = xv[cg][2 * hh] + a1a * (va * ro), x1b = xv[cg][2 * hh + 1] + a1b * (vb * ro);
                xv[cg][2 * hh] = x1a; xv[cg][2 * hh + 1] = x1b;
                *(v4u*)(x1row + 64 * cg + 8 * hh) = (v4u){cvt2bf(x1a.x, x1a.y), cvt2bf(x1a.z, x1a.w), cvt2bf(x1b.x, x1b.y), cvt2bf(x1b.z, x1b.w)}; sx += dot4(x1a, x1a) + dot4(x1b, x1b); }
        sx += __shfl_xor(sx, 16); sx += __shfl_xor(sx, 32);
        if (q == 0) red2[w * 16 + r] = sx;
        P5_BAR();
        float tx = 0.f;
#pragma unroll
        for (int ww = 0; ww < 8; ++ww) tx += red2[ww * 16 + r];
        const float r1 = 1.0f / sqrtf(tx * (1.0f / DM) + EPS);
        unsigned char* hrow = A.H8() + (size_t)m * DM + ko;
        const __amdgpu_buffer_rsrc_t wrs = __builtin_amdgcn_make_buffer_rsrc((void*)A.WR(), 0, 8 * 8 * 5 * 1024, 0x00020000);
#define P5_LDB(c, f) __builtin_bit_cast(f16x8_, __builtin_amdgcn_raw_buffer_load_b128(wrs, lane * 16, ((w * 8 + (c)) * 5 + (f)) * 1024, 0))
        f32x4 acc[5];
#pragma unroll
        for (int nf = 0; nf < 5; ++nf) acc[nf] = (f32x4){0.f, 0.f, 0.f, 0.f};
        f16x8_ bq[5], b1[5], b2[5];
#pragma unroll
        for (int f = 0; f < 5; ++f) { b1[f] = P5_LDB(0, f); b2[f] = P5_LDB(1, f); }
#pragma unroll
        for (int cg = 0; cg < 4; ++cg) {
            unsigned h8[4];
#pragma unroll
            for (int hh = 0; hh < 2; ++hh) {
                const int c = 2 * cg + hh;
#pragma unroll
                for (int f = 0; f < 5; ++f) { bq[f] = b1[f]; b1[f] = b2[f]; }
                if (c + 2 < 8) {
#pragma unroll
                    for (int f = 0; f < 5; ++f) b2[f] = P5_LDB(c + 2, f);
                }
                const f32x4 a2a = *(const LAS f32x4*)(pv + DM + ko + 64 * cg + 8 * hh), a2b = *(const LAS f32x4*)(pv + DM + ko + 64 * cg + 8 * hh + 4);
                const f32x4 a3a = *(const LAS f32x4*)(pv + 2 * DM + ko + 64 * cg + 8 * hh), a3b = *(const LAS f32x4*)(pv + 2 * DM + ko + 64 * cg + 8 * hh + 4);
                const f32x4 ha = xv[cg][2 * hh] * r1 * a2a + a3a, hb = xv[cg][2 * hh + 1] * r1 * a2b + a3b;
                h8[2 * hh] = pk4_fp8(ha.x * SC_H, ha.y * SC_H, ha.z * SC_H, ha.w * SC_H); h8[2 * hh + 1] = pk4_fp8(hb.x * SC_H, hb.y * SC_H, hb.z * SC_H, hb.w * SC_H);
                const unsigned h0 = pkh2(ha.x, ha.y), h1 = pkh2(ha.z, ha.w), h2 = pkh2(hb.x, hb.y), h3 = pkh2(hb.z, hb.w);
                const unsigned l0 = pkh2(ha.x - h_lo(h0), ha.y - h_hi(h0)), l1 = pkh2(ha.z - h_lo(h1), ha.w - h_hi(h1)), l2 = pkh2(hb.x - h_lo(h2), hb.y - h_hi(h2)), l3 = pkh2(hb.z - h_lo(h3), hb.w - h_hi(h3));
                const f16x8_ ahi = __builtin_bit_cast(f16x8_, (v4u){h0, h1, h2, h3}), alo = __builtin_bit_cast(f16x8_, (v4u){l0, l1, l2, l3});
#pragma unroll
                for (int nf = 0; nf < 5; ++nf) { acc[nf] = __builtin_amdgcn_mfma_f32_16x16x32_f16(ahi, bq[nf], acc[nf], 0, 0, 0); acc[nf] = __builtin_amdgcn_mfma_f32_16x16x32_f16(alo, bq[nf], acc[nf], 0, 0, 0); }
            }
            *(v4u*)(hrow + 64 * cg) = (v4u){h8[0], h8[1], h8[2], h8[3]};
        }
#undef P5_LDB
#pragma unroll
        for (int nf = 0; nf < 5; ++nf)
#pragma unroll
            for (int ii = 0; ii < 4; ++ii) part[(w * 16 + 4 * q + ii) * 80 + 16 * nf + r] = acc[nf][ii];
        P5_BAR();
        for (int p = F.tid; p < 16 * 80; p += NWAVES * 64) { const int tok = p / 80, n = p - tok * 80; float sum = 0.f;
#pragma unroll
            for (int ww = 0; ww < 8; ++ww) sum += part[(ww * 16 + tok) * 80 + n];
            lg[p] = sum; }
        P5_BAR();
        if (F.tid < 16) {
            const LAS float* L = lg + F.tid * 80;
            float ac[8];
#pragma unroll
            for (int n = 0; n < 8; ++n) ac[n] = L[n] + A.b_rg()[n];
            int g = 0; float mx = ac[0];
#pragma unroll
            for (int n = 1; n < 8; ++n) if (ac[n] > mx) { mx = ac[n]; g = n; }
            float se = 0.f;
#pragma unroll
            for (int n = 0; n < 8; ++n) se += expf(ac[n] - mx);
            const float pg = 1.0f / se;
            float af[8];
#pragma unroll
            for (int n = 0; n < 8; ++n) af[n] = L[8 + 8 * g + n] + A.b_re()[g * 8 + n];
            int i0 = 0; float v0 = af[0];
#pragma unroll
            for (int n = 1; n < 8; ++n) if (af[n] > v0) { v0 = af[n]; i0 = n; }
            int i1 = -1; float v1 = 0.f;
#pragma unroll
            for (int n = 0; n < 8; ++n) if (n != i0 && (i1 < 0 || af[n] > v1)) { v1 = af[n]; i1 = n; }
            const float ee = expf(v1 - v0), w0 = 1.0f / (1.0f + ee), w1 = ee / (1.0f + ee);
            const int e0 = g * 8 + i0, e1 = g * 8 + i1, mm = mt0 + F.tid, ix = nrec + 2 * F.tid;
            rec_e[ix] = e0; rec_a[ix] = 2 * mm; rec_w[ix] = pg * w0; rec_p[ix] = __hip_atomic_fetch_add(lcnt + e0, 1, __ATOMIC_RELAXED, __HIP_MEMORY_SCOPE_WORKGROUP);
            rec_e[ix + 1] = e1; rec_a[ix + 1] = 2 * mm + 1; rec_w[ix + 1] = pg * w1; rec_p[ix + 1] = __hip_atomic_fetch_add(lcnt + e1, 1, __ATOMIC_RELAXED, __HIP_MEMORY_SCOPE_WORKGROUP);
        }
        nrec += 32;
    }
    P5_BAR();
    if (F.tid < 64) { const int n = lcnt[F.tid]; lbase[F.tid] = n > 0 ? (int)__hip_atomic_fetch_add(A.ctl() + CW_CNT + 64 * F.tid, (unsigned)n, RLX_AGENT) : 0; }
    P5_BAR();
    for (int ix = F.tid; ix < nrec; ix += NWAVES * 64) { const int e = rec_e[ix], slot = lbase[e] + rec_p[ix];
        A.lista()[(size_t)e * LISTCAP + slot] = (int)((unsigned)rec_a[ix] | (cvt2bf(0.f, rec_w[ix]) & 0xffff0000u)); }
}
#undef P5_BAR

struct MUnit { int e, mt, nt, cnt, prow, half; };
constexpr int MOE_MAXU = 24;
__device__ __forceinline__ void moe_tables(const Frame& F, const Args& A) {
    LAS int* T = (LAS int*)(F.lds + TAB_OFF);
    if (F.tid < 64) {
        const int c = (int)__hip_atomic_load(A.ctl() + CW_CNT + 64 * F.tid, RLX_AGENT), full = c >> 8, rem = c & 255;
        int rows = ((c + 255) >> 8) << 8, ua = (full + (rem > 128 ? 1 : 0)) * 8, ub = (rem > 0 && rem <= 128) ? 8 : 0;
        const int rows0 = rows, ua0 = ua, ub0 = ub;
#pragma unroll
        for (int o = 1; o < 64; o <<= 1) { const int r1 = __shfl_up(rows, o), a1 = __shfl_up(ua, o), b1 = __shfl_up(ub, o); if (F.lane >= o) { rows += r1; ua += a1; ub += b1; } }
        T[F.tid] = c; T[64 + F.tid] = rows - rows0; T[128 + F.tid] = ua - ua0; T[200 + F.tid] = ub - ub0;
        if (F.tid == 63) { T[128 + 64] = ua; T[200 + 64] = ub; } }
    __syncthreads();
    const int G = F.G, bx = (int)blockIdx.x, rk = (G % 8 == 0) ? (bx % 8) * (G / 8) + bx / 8 : bx;
    const int UA = T[192], UB = T[264], nu = (UA + UB > rk) ? (UA + UB - rk + G - 1) / G : 0;
    if (F.tid == 0) T[270] = nu < MOE_MAXU ? nu : MOE_MAXU;
    if (F.tid < MOE_MAXU && F.tid < nu) {
        const int p = F.tid * G + rk; int e = 0, mt, nt, half;
        if (p < UA) { for (int q = 1; q < NEXP; ++q) if (p >= T[128 + q]) e = q; const int l = p - T[128 + e]; mt = l >> 3; nt = l & 7; half = 0; }
        else { const int pp = p - UA; for (int q = 1; q < NEXP; ++q) if (pp >= T[200 + q]) e = q; mt = T[e] >> 8; nt = (pp - T[200 + e]) & 7; half = 1; }
        LAS int* d = T + 272 + 4 * F.tid; d[0] = e; d[1] = mt; d[2] = nt; d[3] = half; }
    __syncthreads();
}
struct MoeSched {
    const LAS int* T;
    __device__ __forceinline__ bool next(int i, MUnit& u) const {
        if (i >= T[270]) return false;
        const LAS int* d = T + 272 + 4 * i; const int e = d[0], mt = d[1];
        u.e = __builtin_amdgcn_readfirstlane(e); u.mt = __builtin_amdgcn_readfirstlane(mt); u.nt = __builtin_amdgcn_readfirstlane(d[2]); u.half = __builtin_amdgcn_readfirstlane(d[3]);
        u.cnt = __builtin_amdgcn_readfirstlane(T[e]); u.prow = __builtin_amdgcn_readfirstlane(T[64 + e] + 256 * mt); return true;
    }
};
typedef int v4i_ __attribute__((ext_vector_type(4)));
typedef int v8i_ __attribute__((ext_vector_type(8)));
struct EpiGateUp8 {
    static constexpr bool HAS_PRE = false;
    unsigned char* HID;
    __device__ __forceinline__ void pre(const MUnit&, int, int, int (&)[8]) const {}
    __device__ __forceinline__ void operator()(const pg8::f32x4 (&acc)[2][2][4][2], const MUnit& u, int wr, int wc, int fr, int fq, const int (&)[8]) const {
        unsigned char* tile = HID + ((size_t)(u.prow >> 8) * 8 + u.nt) * 32768; const int rowt = wr * 64 + fr, colt = wc * 32 + 8 * fq; const float sc = 1.0f / (SC_H * SC_WGU);
#pragma unroll
        for (int ai = 0; ai < 2; ++ai) { if (ai == 1 && u.half) break;
#pragma unroll
            for (int m = 0; m < 4; ++m) { unsigned char* rowp = tile + (size_t)(rowt + ai * 128 + m * 16) * 128 + colt;
                pg8::f32x4 a0 = acc[ai][0][m][0] * sc, a1 = acc[ai][0][m][1] * sc; const pg8::f32x4 b0 = acc[ai][1][m][0] * (sc * SC_HID), b1 = acc[ai][1][m][1] * (sc * SC_HID);
#pragma unroll
                for (int i = 0; i < 4; ++i) { a0[i] = a0[i] * sigmoidf_(a0[i]) * b0[i]; a1[i] = a1[i] * sigmoidf_(a1[i]) * b1[i]; }
                *(v2u*)rowp = (v2u){pk4_fp8(a0[0], a0[1], a0[2], a0[3]), pk4_fp8(a1[0], a1[1], a1[2], a1[3])}; } }
    }
};
struct EpiDown8 {
    static constexpr bool HAS_PRE = true;
    bf16* YD; const int* lrec;
    __device__ __forceinline__ void pre(const MUnit& u, int wr, int fr, int (&pa)[8]) const {
#pragma unroll
        for (int ai = 0; ai < 2; ++ai)
#pragma unroll
            for (int m = 0; m < 4; ++m) { const int s = 256 * u.mt + ai * 128 + wr * 64 + m * 16 + fr; const int sc = s < u.cnt ? s : 0;
                pa[ai * 4 + m] = lrec[(size_t)u.e * LISTCAP + sc]; }
    }
    __device__ __forceinline__ void operator()(const pg8::f32x4 (&acc)[2][2][4][2], const MUnit& u, int wr, int wc, int fr, int fq, const int (&pa)[8]) const {
        const int col0 = u.nt * 256 + wc * 32 + 8 * fq;
#pragma unroll
        for (int ai = 0; ai < 2; ++ai)
#pragma unroll
            for (int m = 0; m < 4; ++m) { const int s = 256 * u.mt + ai * 128 + wr * 64 + m * 16 + fr;
                if (s < u.cnt) { const unsigned rc = (unsigned)pa[ai * 4 + m]; const int a = (int)(rc & 0xffffu); const float wgt = bf_hi(rc) * (1.0f / (SC_HID * SC_WD));
                    bf16* rowp = YD + (size_t)a * DM + col0;
#pragma unroll
                    for (int bj = 0; bj < 2; ++bj) { const pg8::f32x4 v0 = acc[ai][bj][m][0] * wgt, v1 = acc[ai][bj][m][1] * wgt;
                        v4u w; w.x = pg8::cvt_pk_bf16(v0[0], v0[1]); w.y = pg8::cvt_pk_bf16(v0[2], v0[3]); w.z = pg8::cvt_pk_bf16(v1[0], v1[1]); w.w = pg8::cvt_pk_bf16(v1[2], v1[3]);
                        *(v4u*)(rowp + bj * 128) = w; } } }
    }
};

template <class Epi, bool GATHER>
__device__ __forceinline__ void gemm_phase_moe8(LAS unsigned char* lds, const unsigned char* Abase, const unsigned char* Wbase, const int KB, const int* lista, const MoeSched& S, const Epi& E, const int wave_id) {
    using namespace pg8;
    int tid_ = wave_id * 64 + lane_id_fresh();
    const int tid = tid_, wid = __builtin_amdgcn_readfirstlane(tid >> 6), lane = tid & 63, wr = wid >> 2, wc = wid & 3, fr = lane & 15, fq = lane >> 4;
    const int nt = KB / 128;
    int Rr[2], Cc[2]; unsigned voffB[2];
#pragma unroll
    for (int i = 0; i < 2; ++i) { int R, C; stage_rc(tid * 16 + i * 8192, R, C); const int Rb = (R & ~31) + perm32(R & 31); Rr[i] = R; Cc[i] = C; voffB[i] = (unsigned)(Rb * 128 + C * 2); }
    const size_t kstep = GATHER ? 128 : 32768;
    const size_t kstepB = (size_t)2048 * 128, hstep = (size_t)HALF * 128;
    const unsigned ldsw = (unsigned)wid * 1024u;
    const int aoff = lds_byte(wr * 64 + fr, fq * 8), boff = lds_byte(wc * 32 + fr, fq * 8);
#define PG8_SA(b, h) (((b) * 2 + (h)) * HTB)
#define PG8_SB(b, h) ((4 + (b) * 2 + (h)) * HTB)
#define PG8_STAGE(bufoff, gbase, voff) do { _Pragma("unroll") for (int _i = 0; _i < 2; ++_i) \
        __builtin_amdgcn_global_load_lds((const unsigned*)((const char*)(gbase) + (voff)[_i]), (PG8_LAS unsigned*)(lds + (bufoff) + ldsw + _i * 8192), 16, 0, 0); } while (0)
#define PG8_STAGE2(bufoff, gbase, o0, o1) do { \
        __builtin_amdgcn_global_load_lds((const unsigned*)((const char*)(gbase) + (o0)), (PG8_LAS unsigned*)(lds + (bufoff) + ldsw), 16, 0, 0); \
        __builtin_amdgcn_global_load_lds((const unsigned*)((const char*)(gbase) + (o1)), (PG8_LAS unsigned*)(lds + (bufoff) + ldsw + 8192), 16, 0, 0); } while (0)
#define PG8_LDA(dst, b, h) do { _Pragma("unroll") for (int m = 0; m < 4; ++m) dst[m] = PG8_CAT(*(const PG8_LAS v4i_*)(lds + PG8_SA(b, h) + aoff + m * 2048), *(const PG8_LAS v4i_*)(lds + PG8_SA(b, h) + aoff + m * 2048 + 1024)); } while (0)
#define PG8_LDB(dst, b, h) do { _Pragma("unroll") for (int n = 0; n < 2; ++n) dst[n] = PG8_CAT(*(const PG8_LAS v4i_*)(lds + PG8_SB(b, h) + boff + n * 2048), *(const PG8_LAS v4i_*)(lds + PG8_SB(b, h) + boff + n * 2048 + 1024)); } while (0)
#define PG8_MMA(ai, bj, At, Bt) do { __builtin_amdgcn_s_setprio(1); _Pragma("unroll") for (int m = 0; m < 4; ++m) _Pragma("unroll") for (int n = 0; n < 2; ++n) \
        asm volatile("v_mfma_f32_16x16x128_f8f6f4 %0, %1, %2, %0" : "+v"(acc[ai][bj][m][n]) : "v"(Bt[n]), "v"(At[m])); __builtin_amdgcn_s_setprio(0); } while (0)
#define PG8_MFMA_DRAIN() asm volatile("s_nop 15\n\ts_nop 15" ::: "memory")
#define PG8_CAT(x, y) __builtin_shufflevector((x), (y), 0, 1, 2, 3, 4, 5, 6, 7)
#define PG8_WAIT_V(n) asm volatile("s_waitcnt vmcnt(" #n ")" ::: "memory")
#define PG8_WAIT_L(n) asm volatile("s_waitcnt lgkmcnt(" #n ")" ::: "memory")
#define PG8_BAR __builtin_amdgcn_s_barrier()
#define PG8_SCHED __builtin_amdgcn_sched_barrier(0)
#define MOE_ROWOFF(dst, u, h, i) do { const int _s = 256 * (u).mt + 128 * (h) + Rr[i]; \
        if (GATHER) { int _tok = 0; if (_s < (u).cnt) _tok = (lista[(size_t)(u).e * LISTCAP + _s] & 0xffff) >> 1; dst = (unsigned)_tok * (unsigned)KB + (unsigned)(Cc[i] * 2); } \
        else dst = (unsigned)((u).prow >> 8) * (unsigned)(KB * 256) + (unsigned)(128 * (h) + Rr[i]) * 128u + (unsigned)(Cc[i] * 2); } while (0)
    MUnit cur, nxt; int ui = 0;
    if (!S.next(0, cur)) return;
    f32x4 acc[2][2][4][2];
#pragma unroll
    for (int a = 0; a < 2; ++a)
#pragma unroll
        for (int b = 0; b < 2; ++b)
#pragma unroll
            for (int m = 0; m < 4; ++m)
#pragma unroll
                for (int n = 0; n < 2; ++n) acc[a][b][m][n] = (f32x4){0.f, 0.f, 0.f, 0.f};
    v8i_ At[4], B0[2], B1[2];
    unsigned c00, c01, c10, c11, n00, n01, n10, n11;
    MOE_ROWOFF(c00, cur, 0, 0); MOE_ROWOFF(c01, cur, 0, 1); MOE_ROWOFF(c10, cur, 1, 0); MOE_ROWOFF(c11, cur, 1, 1);
    const char* const cA = (const char*)Abase;
    const char* cB = (const char*)Wbase + (size_t)cur.e * 2048 * KB + (size_t)cur.nt * 32768;
    PG8_STAGE(PG8_SB(0, 0), cB, voffB); PG8_STAGE(PG8_SB(0, 1), cB + hstep, voffB); PG8_STAGE2(PG8_SA(0, 0), cA, c00, c01); PG8_STAGE2(PG8_SA(0, 1), cA, c10, c11);
    if (wr == 1) PG8_BAR;
    PG8_WAIT_V(2); PG8_BAR;
    PG8_STAGE(PG8_SB(1, 0), cB + kstepB, voffB); PG8_STAGE2(PG8_SA(1, 0), cA + kstep, c00, c01); PG8_STAGE(PG8_SB(1, 1), cB + hstep + kstepB, voffB);
    PG8_WAIT_V(6); PG8_BAR;
    for (;;) {
        const bool has_next = S.next(ui + 1, nxt);
        const char* nB = cB;
        n00 = c00; n01 = c01; n10 = c10; n11 = c11;
        if (has_next) { MOE_ROWOFF(n00, nxt, 0, 0); MOE_ROWOFF(n01, nxt, 0, 1); MOE_ROWOFF(n10, nxt, 1, 0); MOE_ROWOFF(n11, nxt, 1, 1);
            nB = (const char*)Wbase + (size_t)nxt.e * 2048 * KB + (size_t)nxt.nt * 32768; }
        int pa[8];
        const bool chalf = cur.half != 0;
        for (int t = 0; t < nt; t += 2) {
            const bool last = (t == nt - 2);
            const char* a1 = cA + (size_t)(t + 1) * kstep;
            const char* a2 = last ? cA : cA + (size_t)(t + 2) * kstep; const char* b2 = last ? nB : cB + (size_t)(t + 2) * kstepB;
            const char* a3 = a2 + kstep; const char* b3 = b2 + kstepB;
            unsigned x00 = c00, x01 = c01, x10 = c10, x11 = c11;
            if (last) { if (Epi::HAS_PRE) E.pre(cur, wr, fr, pa);
                asm volatile("" : "+v"(n00), "+v"(n01), "+v"(n10), "+v"(n11));
                x00 = n00; x01 = n01; x10 = n10; x11 = n11; }
            PG8_LDB(B0, 0, 0); PG8_LDB(B1, 0, 1); PG8_SCHED; PG8_LDA(At, 0, 0); PG8_STAGE2(PG8_SA(1, 1), a1, c10, c11);
            PG8_WAIT_V(8); PG8_WAIT_L(0); PG8_BAR; PG8_MMA(0, 0, At, B0); PG8_MMA(0, 1, At, B1); PG8_BAR; PG8_SCHED;
            if (!chalf) PG8_LDA(At, 0, 1);
            PG8_STAGE(PG8_SB(0, 0), b2, voffB); PG8_STAGE(PG8_SB(0, 1), b2 + hstep, voffB); PG8_STAGE2(PG8_SA(0, 0), a2, x00, x01);
            PG8_WAIT_V(8); PG8_WAIT_L(0); PG8_BAR; if (!chalf) { PG8_MMA(1, 0, At, B0); PG8_MMA(1, 1, At, B1); } PG8_BAR; PG8_SCHED;
            PG8_LDB(B0, 1, 0); PG8_LDB(B1, 1, 1); PG8_SCHED; PG8_LDA(At, 1, 0); PG8_STAGE2(PG8_SA(0, 1), a2, x10, x11);
            PG8_WAIT_V(8); PG8_WAIT_L(0); PG8_BAR; PG8_MMA(0, 0, At, B0); PG8_MMA(0, 1, At, B1); PG8_BAR; PG8_SCHED;
            if (!chalf) PG8_LDA(At, 1, 1);
            PG8_STAGE(PG8_SB(1, 0), b3, voffB); PG8_STAGE(PG8_SB(1, 1), b3 + hstep, voffB); PG8_STAGE2(PG8_SA(1, 0), a3, x00, x01);
            PG8_WAIT_V(8); PG8_WAIT_L(0); PG8_BAR; if (!chalf) { PG8_MMA(1, 0, At, B0); PG8_MMA(1, 1, At, B1); } PG8_BAR; PG8_SCHED;
        }
        if (wr == 0) PG8_BAR;
        PG8_MFMA_DRAIN();
        E(acc, cur, wr, wc, fr, fq, pa);
        if (!has_next) break;
#pragma unroll
        for (int a = 0; a < 2; ++a)
#pragma unroll
            for (int b = 0; b < 2; ++b)
#pragma unroll
                for (int m = 0; m < 4; ++m)
#pragma unroll
                    for (int n = 0; n < 2; ++n) acc[a][b][m][n] = (f32x4){0.f, 0.f, 0.f, 0.f};
        cur = nxt; cB = nB; c00 = n00; c01 = n01; c10 = n10; c11 = n11; ++ui;
        if (wr == 1) PG8_BAR;
    }
    PG8_WAIT_V(0);
    PG8_BAR;
#undef MOE_ROWOFF
#undef PG8_SA
#undef PG8_SB
#undef PG8_STAGE
#undef PG8_STAGE2
#undef PG8_LDA
#undef PG8_LDB
#undef PG8_MMA
#undef PG8_MFMA_DRAIN
#undef PG8_CAT
#undef PG8_WAIT_V
#undef PG8_WAIT_L
#undef PG8_BAR
#undef PG8_SCHED
}

__device__ __forceinline__ void p8_row_load(const Args& A, int m, int lane, f32x4 (&xv)[8], f32x4 (&yv)[8]) {
    const v2u* xr = (const v2u*)(A.X1() + (size_t)m * DM) + lane;
    const v2u* y0 = (const v2u*)(A.YD() + (size_t)(2 * m) * DM) + lane;
    const v2u* y1 = (const v2u*)(A.YD() + (size_t)(2 * m + 1) * DM) + lane;
#pragma unroll
    for (int j = 0; j < 8; ++j) { const v2u xx = xr[64 * j]; xv[j] = (f32x4){bf_lo(xx.x), bf_hi(xx.x), bf_lo(xx.y), bf_hi(xx.y)}; const v2u p = y0[64 * j], q = y1[64 * j];
        yv[j] = (f32x4){bf_lo(p.x) + bf_lo(q.x), bf_hi(p.x) + bf_hi(q.x), bf_lo(p.y) + bf_lo(q.y), bf_hi(p.y) + bf_hi(q.y)}; }
}
__device__ __forceinline__ void p8_row_finish(const Args& A, int m, int lane, const f32x4 (&xv)[8], const f32x4 (&yv)[8], const f32x4 (&gg)[8]) {
    float s = 0.f;
#pragma unroll
    for (int j = 0; j < 8; ++j) s += dot4(yv[j], yv[j]);
    const float r = 1.0f / sqrtf(wave_sum(s) * (1.0f / DM) + EPS);
    f32x4* outr = (f32x4*)(A.out() + (size_t)m * DM) + lane;
#pragma unroll
    for (int j = 0; j < 8; ++j) outr[64 * j] = xv[j] + gg[j] * (yv[j] * r);
}
__device__ __forceinline__ void p8_final(const Frame& F, const Args& A) {
    const int gw = F.vcu * NWAVES + F.wave, NGW = F.G * NWAVES, lane = F.lane;
    f32x4 gg[8]; int bcur = -1;
    for (int m0 = gw; m0 < NTOK; m0 += 2 * NGW) {
        const int m1 = m0 + NGW; const bool has1 = (m1 < NTOK) && ((m1 >> 14) == (m0 >> 14));
        f32x4 xa[8], ya[8], xb[8], yb[8];
        p8_row_load(A, m0, lane, xa, ya);
        p8_row_load(A, has1 ? m1 : m0, lane, xb, yb);
        if ((m0 >> 14) != bcur) { bcur = m0 >> 14; const f32x4* gp = (const f32x4*)A.g_post2() + lane; const f32x4* g2 = (const f32x4*)(A.mod() + bcur * NMODC + 5 * DM) + lane;
#pragma unroll
            for (int j = 0; j < 8; ++j) gg[j] = gp[64 * j] * g2[64 * j]; }
        p8_row_finish(A, m0, lane, xa, ya, gg);
        if (has1) p8_row_finish(A, m1, lane, xb, yb, gg);
        else if (m1 < NTOK) { m0 -= NGW; }
    }
}
#ifndef PHMASK
#define PHMASK 511
#endif
#ifndef GEMM2_SHARE
#define GEMM2_SHARE 27
#endif
#ifndef GEMM4_SHARE
#define GEMM4_SHARE 26
#endif
#ifndef REPMASK
#define REPMASK 0
#endif
#define REPS(k) (((REPMASK >> (k)) & 1) ? 2 : 1)

__global__ void __launch_bounds__(NWAVES * 64, 2) mk_fwd(Args args) {
    extern __shared__ __attribute__((aligned(16))) unsigned char lds[];
    Frame F;
    F.lds = (LAS unsigned char*)lds;
    F.tid = threadIdx.x; F.lane = F.tid & 63; F.wave = __builtin_amdgcn_readfirstlane(F.tid >> 6);
    F.G = gridDim.x; { const int bx = blockIdx.x; F.vcu = (F.G % 8 == 0) ? (bx % 8) * (F.G / 8) + bx / 8 : bx; }
    const Args& A = args;
    for (int u = F.tid; u < (LDS_BYTES - LDSCTL_OFF) / 4; u += NWAVES * 64) ((LAS unsigned*)(F.lds + LDSCTL_OFF))[u] = 0u;
    __syncthreads();
#ifdef TLSEL
    unsigned tl_acc = 0;
#define TL_NOW() ((unsigned)__builtin_amdgcn_s_memrealtime())
#define TL_AT(sel, ...) do { if (TLSEL == (sel)) { __VA_ARGS__; } } while (0)
#else
#define TL_AT(sel, ...) do {} while (0)
#endif
    XcdBarrier bar = xcd_barrier_post(A.ctl() + CW_BAR, (volatile LAS unsigned*)(F.lds + LDSCTL_OFF));

#if PHMASK & 1
    p0_ada(phase_frame(F), A); p0_router_weights(phase_frame(F), A); p0_weights(phase_frame(F), A);
#ifdef ISO_CONV
    __syncthreads(); if ((int)blockIdx.x >= ISO_CONV) expert_worker(phase_frame(F), A, 0u);
#endif
    if (REPS(0) == 2) { __syncthreads(); p0_ada(phase_frame(F), A); p0_weights(phase_frame(F), A); }
#endif
    xcd_barrier(bar, F.wave);
#if PHMASK & 2
    p1_norm1(phase_frame(F), A);
    if (REPS(1) == 2) p1_norm1(phase_frame(F), A);
#endif
    xcd_barrier(bar, F.wave);
#if PHMASK & 4
    {
        const int NG2 = (F.G % 8 == 0 && F.G >= 64) ? (F.G / 8 * GEMM2_SHARE / 32) * 8 : F.G;
        TL_AT(10, tl_acc -= TL_NOW()); TL_AT(13, tl_acc -= TL_NOW());
        if ((int)blockIdx.x < NG2) {
            pg8::Gemm g{A.H(), A.WIN(), NTOK, DINP, DM}; pg8::StaticOrder S; S.init(NTOK, DINP, NG2, (int)blockIdx.x);
            EpiInProj E{A.P()};
            pg8::gemm_phase<EpiInProj, pg8::StaticOrder, true, true>(F.lds + RING_OFF, g, S, E, F.wave);
            if (threadIdx.x == 0) __hip_atomic_fetch_add(A.ctl() + CW_DONE, 1u, RLX_AGENT);
        }
        TL_AT(13, tl_acc += TL_NOW());
        expert_worker(phase_frame(F), A, (unsigned)NG2);
        TL_AT(10, tl_acc += TL_NOW()); }
    if (REPS(2) == 2) {   pg8::Gemm g{A.H(), A.WIN(), NTOK, DINP, DM}; pg8::StaticOrder S; S.init(NTOK, DINP, F.G, (int)blockIdx.x);
        EpiInProj E{A.P()};
        pg8::gemm_phase<EpiInProj, pg8::StaticOrder, true, true>(F.lds + RING_OFF, g, S, E, F.wave); }
#endif
    xcd_barrier(bar, F.wave);
    TL_AT(12, { unsigned q = __hip_atomic_load(A.ctl() + CW_Q, RLX_AGENT); tl_acc = q < 12288u ? q : 12288u; });
#if PHMASK & 8
    p3_mix(phase_frame(F), A);
    if (REPS(3) == 2) p3_mix(phase_frame(F), A);
#endif
    xcd_barrier(bar, F.wave);
#if PHMASK & 16
    {
        const int NG2 = (F.G % 8 == 0 && F.G >= 64) ? (F.G / 8 * GEMM2_SHARE / 32) * 8 : F.G;
        const int NG4 = (F.G % 8 == 0 && F.G >= 64) ? (F.G / 8 * GEMM4_SHARE / 32) * 8 : F.G;
        if ((int)blockIdx.x < NG4) {
            pg8::Gemm g{A.Y(), A.WOUT(), NTOK, DM, DM}; pg8::StaticOrder S; S.init(NTOK, DM, NG4, (int)blockIdx.x);
            EpiStoreFrag E{A.O(), DM / 256};
            pg8::gemm_phase<EpiStoreFrag, pg8::StaticOrder, true, true>(F.lds + RING_OFF, g, S, E, F.wave);
            if (threadIdx.x == 0) __hip_atomic_fetch_add(A.ctl() + CW_DONE, 1u, RLX_AGENT);
        }
        expert_worker(phase_frame(F), A, (unsigned)(NG2 + NG4)); }
    if (REPS(4) == 2) {   pg8::Gemm g{A.Y(), A.WOUT(), NTOK, DM, DM}; pg8::StaticOrder S; S.init(NTOK, DM, F.G, (int)blockIdx.x);
        EpiStoreFrag E{A.O(), DM / 256};
        pg8::gemm_phase<EpiStoreFrag, pg8::StaticOrder, true, true>(F.lds + RING_OFF, g, S, E, F.wave); }
#endif
    xcd_barrier(bar, F.wave);
#if PHMASK & 32
    p5_norm2_router(phase_frame(F), A);
    __syncthreads();
    TL_AT(11, tl_acc -= TL_NOW());
    expert_worker(phase_frame(F), A, 0u);
    TL_AT(11, tl_acc += TL_NOW());
#endif
    xcd_barrier(bar, F.wave);
    moe_tables(phase_frame(F), A);
    MoeSched MS; MS.T = (const LAS int*)(F.lds + TAB_OFF);
#if PHMASK & 64
#ifdef REP6LOOP
    for (int rep = 0; rep < 2; ++rep)
#endif
    {   EpiGateUp8 E{A.HID()};
        gemm_phase_moe8<EpiGateUp8, true>(F.lds + RING_OFF, A.H8(), A.WGU(), DM, A.lista(), MS, E, F.wave); }
#endif
    xcd_barrier(bar, F.wave);
#if PHMASK & 128
#ifdef REP7LOOP
    for (int rep = 0; rep < 2; ++rep)
#endif
    {   EpiDown8 E{A.YD(), A.lista()};
        gemm_phase_moe8<EpiDown8, false>(F.lds + RING_OFF, A.HID(), A.WD(), DEXP, A.lista(), MS, E, F.wave); }
#endif
    xcd_barrier(bar, F.wave);
#if PHMASK & 256
    p8_final(phase_frame(F), A);
#endif
#ifdef TLSEL
    if (blockIdx.x == 0 && F.wave == 0) { const unsigned long long t0 = __builtin_amdgcn_s_memrealtime(), w = (unsigned long long)tl_acc * TLMUL;
        while (__builtin_amdgcn_s_memrealtime() - t0 < w) __builtin_amdgcn_s_sleep(8); }
#endif
}

extern "C" void kernel_launch(void* const* d_in, const int* in_sizes, int n_in, void* d_out, int out_size, void* d_ws, size_t ws_size, hipStream_t stream) {
    static int grid = 0;
    if (grid == 0) {
        if (n_in != 23 || in_sizes[0] != NTOK * DM || out_size != NTOK * DM || ws_size < WS_END) { fprintf(stderr, "kernel_launch: unexpected shapes (n_in %d, in0 %d, out %d, ws %zu)\n", n_in, n_in > 0 ? in_sizes[0] : -1, out_size, ws_size); grid = -1; return; }
        int dev = 0, cus = 0, per_cu = 0;
        if (hipGetDevice(&dev) != hipSuccess || hipDeviceGetAttribute(&cus, hipDeviceAttributeMultiprocessorCount, dev) != hipSuccess) { grid = -1; return; }
        if (hipFuncSetAttribute((const void*)mk_fwd, hipFuncAttributeMaxDynamicSharedMemorySize, LDS_BYTES) != hipSuccess) { fprintf(stderr, "kernel_launch: hipFuncSetAttribute failed\n"); grid = -1; return; }
        if (hipOccupancyMaxActiveBlocksPerMultiprocessor(&per_cu, (const void*)mk_fwd, NWAVES * 64, LDS_BYTES) != hipSuccess || per_cu < 1) { fprintf(stderr, "kernel_launch: occupancy query says %d\n", per_cu); }
        (void)hipGetLastError();
        grid = cus;
    }
    if (grid < 0) return;
    if (hipMemsetAsync((char*)d_ws + WS_CTL, 0, CTL_ZERO_BYTES, stream) != hipSuccess) return;
    Args a{};
    for (int i = 0; i < 23; ++i) a.in[i] = (const float*)d_in[i];
    a.out_ = (float*)d_out; a.ws = (unsigned char*)d_ws;
    hipLaunchKernelGGL(mk_fwd, dim3(grid), dim3(NWAVES * 64), LDS_BYTES, stream, a);
}
```

```cpp
#include <hip/hip_runtime.h>
#include <cstdio>
#include <cstdint>
#define GEMM2_SHARE 25
namespace pg8 {
#define PG8_LAS __attribute__((address_space(3)))
typedef unsigned short bf16_t;
typedef short bf16x8 __attribute__((ext_vector_type(8)));
typedef float f32x4 __attribute__((ext_vector_type(4)));
typedef unsigned u32x4 __attribute__((ext_vector_type(4)));
constexpr int BM = 256, BK = 64, HALF = 128, HTB = HALF * BK * 2  , STAGE_BYTES = 8 * HTB, NXCD = 8, WGM = 8;

__host__ __device__ __forceinline__ int lds_byte(int r, int c) { const int st = (r >> 4) * 2 + (c >> 5), rr = r & 15, cc = c & 31, ob = rr * 64 + cc * 2; return st * 1024 + (ob ^ (((ob >> 9) & 1) << 5)); }
__host__ __device__ __forceinline__ void stage_rc(int b, int& R, int& C) { const int st = b / 1024, sb = b % 1024, swz = sb ^ (((sb >> 9) & 1) << 5); R = (st >> 1) * 16 + swz / 64; C = (st & 1) * 32 + (swz % 64) / 2; }
__host__ __device__ __forceinline__ int perm32(int rho) { const int n = rho >> 4, i = rho & 15; return 8 * (i >> 2) + 4 * n + (i & 3); }

struct Unit { int pm, pn; };
struct Gemm { const bf16_t* A; const bf16_t* Bt; int M, N, K; };

struct StaticOrder {
    int nM, nN, nwg, G, c;
    __host__ __device__ void init(int M, int N, int G_, int c_) { nM = M / BM; nN = N / BM; nwg = nM * nN; G = G_; c = c_; }
    __host__ __device__ bool next(int i, Unit& u) const {
        const long L = (long)i * G + c; if (L >= nwg) return false;
        int wgid = (int)L; { const int q = nwg / NXCD, r = nwg % NXCD, xcd = wgid % NXCD, off = wgid / NXCD; wgid = (xcd < r ? xcd * (q + 1) : r * (q + 1) + (xcd - r) * q) + off; }
        const int nig = WGM * nN, gid = wgid / nig, fm = gid * WGM, gsz = (nM - fm) < WGM ? (nM - fm) : WGM;
        u.pm = fm + ((wgid % nig) % gsz); u.pn = (wgid % nig) / gsz; return true;
    }
    __device__ __forceinline__ void a_ready(const Unit&) const {}
    __device__ __forceinline__ void done(const Unit&) const {}
};

__device__ __forceinline__ unsigned cvt_pk_bf16(float lo, float hi) { unsigned r; asm volatile("v_cvt_pk_bf16_f32 %0, %1, %2" : "=v"(r) : "v"(lo), "v"(hi)); return r; }
typedef float f32x2 __attribute__((ext_vector_type(2)));
typedef float f32x2 __attribute__((ext_vector_type(2)));
template <class Epi, class Sched, bool ALIGN_EPI = false, bool SP2 = false>
__device__ __forceinline__ void gemm_phase(PG8_LAS unsigned char* lds, const Gemm g, const Sched& S, const Epi& E, const int wave_id) {
    int tid_; asm volatile("v_mbcnt_lo_u32_b32 %0, -1, 0\n\tv_mbcnt_hi_u32_b32 %0, -1, %0" : "=v"(tid_)); tid_ += wave_id * 64;
    const int tid = tid_, wid = __builtin_amdgcn_readfirstlane(tid >> 6), lane = tid & 63, wr = wid >> 2, wc = wid & 3, fr = lane & 15, fq = lane >> 4;
    const int K = g.K, nt = K / BK;
    unsigned voffA[2], voffB[2];
#pragma unroll
    for (int i = 0; i < 2; ++i) { int R, C; stage_rc(tid * 16 + i * 8192, R, C); const int Rb = Epi::PERM ? ((R & ~31) + perm32(R & 31)) : R;
        voffA[i] = (unsigned)(R * K + C) * 2u; voffB[i] = (unsigned)(Rb * K + C) * 2u; }
    const size_t kstep = (size_t)(BK * 2);
    const size_t hstep = (size_t)HALF * K * 2;
    const size_t tstep = 2 * hstep;
    const unsigned ldsw = (unsigned)wid * 1024u;
    const int aoff = lds_byte(wr * 64 + fr, fq * 8), boff = lds_byte(wc * 32 + fr, fq * 8);
#define PG8_SA(b, h) (((b) * 2 + (h)) * HTB)
#define PG8_SB(b, h) ((4 + (b) * 2 + (h)) * HTB)
#define PG8_STAGE(bufoff, gbase, voff) do { _Pragma("unroll") for (int _i = 0; _i < 2; ++_i) { const char* _gb = (const char*)(gbase); asm volatile("" : "+s"(_gb));     \
        __builtin_amdgcn_global_load_lds((const unsigned*)(_gb + (voff)[_i]), (PG8_LAS unsigned*)(lds + (bufoff) + ldsw + _i * 8192), 16, 0, 0); } } while (0)
#define PG8_LDA(dst, b, h) do { _Pragma("unroll") for (int m = 0; m < 4; ++m) _Pragma("unroll") for (int k = 0; k < 2; ++k) dst[m][k] = *(const PG8_LAS bf16x8*)(lds + PG8_SA(b, h) + aoff + m * 2048 + k * 1024); } while (0)
#define PG8_LDB(dst, b, h) do { _Pragma("unroll") for (int n = 0; n < 2; ++n) _Pragma("unroll") for (int k = 0; k < 2; ++k) dst[n][k] = *(const PG8_LAS bf16x8*)(lds + PG8_SB(b, h) + boff + n * 2048 + k * 1024); } while (0)
#define PG8_MMA(ai, bj, At, Bt) do { __builtin_amdgcn_s_setprio(1); _Pragma("unroll") for (int m = 0; m < 4; ++m) _Pragma("unroll") for (int n = 0; n < 2; ++n) _Pragma("unroll") for (int k = 0; k < 2; ++k) \
        acc[ai][bj][m][n] = __builtin_amdgcn_mfma_f32_16x16x32_bf16(Bt[n][k], At[m][k], acc[ai][bj][m][n], 0, 0, 0); __builtin_amdgcn_s_setprio(0); } while (0)
#define PG8_WAIT_V(n) asm volatile("s_waitcnt vmcnt(" #n ")" ::: "memory")
#define PG8_WAIT_L(n) asm volatile("s_waitcnt lgkmcnt(" #n ")" ::: "memory")
#define PG8_BAR __builtin_amdgcn_s_barrier()
#define PG8_SCHED __builtin_amdgcn_sched_barrier(0)
    Unit cur, nxt; int ui = 0;
    if (!S.next(0, cur)) return;
    f32x4 acc[2][2][4][2];
#pragma unroll
    for (int a = 0; a < 2; ++a)
#pragma unroll
        for (int b = 0; b < 2; ++b)
#pragma unroll
            for (int m = 0; m < 4; ++m)
#pragma unroll
                for (int n = 0; n < 2; ++n) acc[a][b][m][n] = (f32x4){0.f, 0.f, 0.f, 0.f};
    bf16x8 At[4][2], B0[2][2], B1[2][2];
    const char* cA = (const char*)g.A + (size_t)cur.pm * tstep; const char* cB = (const char*)g.Bt + (size_t)cur.pn * tstep;
    S.a_ready(cur);
    if constexpr (SP2) {
        PG8_STAGE(PG8_SB(0, 0), cB, voffB); PG8_STAGE(PG8_SB(0, 1), cB + hstep, voffB); PG8_STAGE(PG8_SA(0, 0), cA, voffA); PG8_STAGE(PG8_SA(0, 1), cA + hstep, voffA);
        if (wr == 1) PG8_BAR;
        PG8_WAIT_V(2); PG8_BAR;
        PG8_STAGE(PG8_SB(1, 0), cB + kstep, voffB); PG8_STAGE(PG8_SA(1, 0), cA + kstep, voffA); PG8_STAGE(PG8_SB(1, 1), cB + hstep + kstep, voffB);
        PG8_WAIT_V(6); PG8_BAR;
    } else {
        PG8_STAGE(PG8_SB(0, 0), cB, voffB); PG8_STAGE(PG8_SA(0, 0), cA, voffA); PG8_STAGE(PG8_SB(0, 1), cB + hstep, voffB); PG8_STAGE(PG8_SA(0, 1), cA + hstep, voffA);
        if (wr == 1) PG8_BAR;
        PG8_WAIT_V(4); PG8_BAR;
        PG8_STAGE(PG8_SB(1, 0), cB + kstep, voffB); PG8_STAGE(PG8_SA(1, 0), cA + kstep, voffA); PG8_STAGE(PG8_SB(1, 1), cB + hstep + kstep, voffB);
        PG8_WAIT_V(6); PG8_BAR;
    }
    for (;;) {
        const bool has_next = S.next(ui + 1, nxt);
        const char* nA = has_next ? (const char*)g.A + (size_t)nxt.pm * tstep : cA; const char* nB = has_next ? (const char*)g.Bt + (size_t)nxt.pn * tstep : cB;
        for (int t = 0; t < nt; t += 2) {
            const bool last = (t == nt - 2);
            const char* a1 = cA + (size_t)(t + 1) * kstep;
            const char* a2 = last ? nA : cA + (size_t)(t + 2) * kstep; const char* b2 = last ? nB : cB + (size_t)(t + 2) * kstep;
            const char* a3 = a2 + kstep; const char* b3 = b2 + kstep;
            if (last && has_next) S.a_ready(nxt);
            if constexpr (SP2) {
            PG8_LDB(B0, 0, 0); PG8_LDB(B1, 0, 1); PG8_SCHED; PG8_LDA(At, 0, 0); PG8_STAGE(PG8_SA(1, 1), a1 + hstep, voffA);
            PG8_WAIT_V(8); PG8_WAIT_L(0); PG8_BAR; PG8_MMA(0, 0, At, B0); PG8_MMA(0, 1, At, B1); PG8_BAR; PG8_SCHED;
            PG8_LDA(At, 0, 1); PG8_STAGE(PG8_SB(0, 0), b2, voffB); PG8_STAGE(PG8_SB(0, 1), b2 + hstep, voffB); PG8_STAGE(PG8_SA(0, 0), a2, voffA);
            PG8_WAIT_V(8); PG8_WAIT_L(0); PG8_BAR; PG8_MMA(1, 0, At, B0); PG8_MMA(1, 1, At, B1); PG8_BAR; PG8_SCHED;
            PG8_LDB(B0, 1, 0); PG8_LDB(B1, 1, 1); PG8_SCHED; PG8_LDA(At, 1, 0); PG8_STAGE(PG8_SA(0, 1), a2 + hstep, voffA);
            PG8_WAIT_V(8); PG8_WAIT_L(0); PG8_BAR; PG8_MMA(0, 0, At, B0); PG8_MMA(0, 1, At, B1); PG8_BAR; PG8_SCHED;
            PG8_LDA(At, 1, 1); PG8_STAGE(PG8_SB(1, 0), b3, voffB); PG8_STAGE(PG8_SB(1, 1), b3 + hstep, voffB); PG8_STAGE(PG8_SA(1, 0), a3, voffA);
            PG8_WAIT_V(8); PG8_WAIT_L(0); PG8_BAR; PG8_MMA(1, 0, At, B0); PG8_MMA(1, 1, At, B1); PG8_BAR; PG8_SCHED;
            } else {
            PG8_LDB(B0, 0, 0); PG8_SCHED; PG8_LDA(At, 0, 0); PG8_STAGE(PG8_SA(1, 1), a1 + hstep, voffA);
            PG8_WAIT_L(8); PG8_BAR; PG8_WAIT_L(0); PG8_MMA(0, 0, At, B0); PG8_BAR; PG8_SCHED;
            PG8_LDB(B1, 0, 1); PG8_STAGE(PG8_SB(0, 0), b2, voffB);
            PG8_BAR; PG8_WAIT_L(0); PG8_MMA(0, 1, At, B1); PG8_BAR;
            PG8_LDA(At, 0, 1); PG8_STAGE(PG8_SA(0, 0), a2, voffA);
            PG8_BAR; PG8_WAIT_L(0); PG8_MMA(1, 0, At, B0); PG8_BAR; PG8_SCHED;
            PG8_STAGE(PG8_SB(0, 1), b2 + hstep, voffB);
            PG8_WAIT_V(6); PG8_BAR; PG8_MMA(1, 1, At, B1); PG8_BAR;
            PG8_LDB(B0, 1, 0); PG8_SCHED; PG8_LDA(At, 1, 0); PG8_STAGE(PG8_SA(0, 1), a2 + hstep, voffA);
            PG8_WAIT_L(8); PG8_BAR; PG8_WAIT_L(0); PG8_MMA(0, 0, At, B0); PG8_BAR; PG8_SCHED;
            PG8_LDB(B1, 1, 1); PG8_STAGE(PG8_SB(1, 0), b3, voffB);
            PG8_BAR; PG8_WAIT_L(0); PG8_MMA(0, 1, At, B1); PG8_BAR;
            PG8_LDA(At, 1, 1); PG8_STAGE(PG8_SA(1, 0), a3, voffA);
            PG8_BAR; PG8_WAIT_L(0); PG8_MMA(1, 0, At, B0); PG8_BAR; PG8_SCHED;
            PG8_STAGE(PG8_SB(1, 1), b3 + hstep, voffB);
            PG8_WAIT_V(6); PG8_BAR; PG8_MMA(1, 1, At, B1); PG8_BAR;
            }
        }
        if constexpr (ALIGN_EPI) { if (wr == 0) PG8_BAR; }
        if constexpr (!Epi::AFTER_DRAIN) { E(acc, cur, wr, wc, fr, fq); S.done(cur); }
        if (!has_next) break;
#pragma unroll
        for (int a = 0; a < 2; ++a)
#pragma unroll
            for (int b = 0; b < 2; ++b)
#pragma unroll
                for (int m = 0; m < 4; ++m)
#pragma unroll
                    for (int n = 0; n < 2; ++n) acc[a][b][m][n] = (f32x4){0.f, 0.f, 0.f, 0.f};
        cur = nxt; cA = nA; cB = nB; ++ui;
        if constexpr (ALIGN_EPI) { if (wr == 1) PG8_BAR; }
    }
    PG8_WAIT_V(0);
    if constexpr (!ALIGN_EPI) { if (wr == 0) PG8_BAR; }
    PG8_BAR;
    if constexpr (Epi::AFTER_DRAIN) { E.fused(acc, cur, wr, wc, fr, fq, lds, wid, lane); S.done(cur); }
#undef PG8_SA
#undef PG8_SB
#undef PG8_STAGE
#undef PG8_LDA
#undef PG8_LDB
#undef PG8_MMA
#undef PG8_WAIT_V
#undef PG8_WAIT_L
#undef PG8_BAR
#undef PG8_SCHED
}
}

constexpr int NWAVES = 8;
constexpr int DM = 2048, SEQ = 16384, NBATCH = 2, NTOK = NBATCH * SEQ;
constexpr int DCA = 1024, DINP = 5120, NEXP = 64, DEXP = 1024, LISTCAP = 32768, NMODC = 6 * DM;
constexpr int PW = 3072;
constexpr float EPS = 1e-6f;

constexpr size_t MiB = 1u << 20;
constexpr size_t WS_CTL = 0, CTL_ZERO_BYTES = 65536;
constexpr size_t WS_MOD = 1 * MiB;
constexpr size_t WS_WIN = 2 * MiB;
constexpr size_t WS_WOUT = 22 * MiB;
constexpr size_t WS_LISTA = 30 * MiB;
constexpr size_t WS_LISTW = 38 * MiB;
constexpr size_t WS_WR = 46 * MiB;
constexpr size_t WS_WGU = 64 * MiB;
constexpr size_t WS_WD = 576 * MiB;
constexpr size_t WS_H = 832 * MiB;
constexpr size_t WS_P = 960 * MiB;
constexpr size_t WS_Y = 1152 * MiB;
constexpr size_t WS_O = 1280 * MiB;
constexpr size_t WS_X1 = 1410 * MiB;
constexpr size_t WS_END = 1538 * MiB;
constexpr int CW_TMO = 0, CW_Q = 64, CW_DONE = 128, CW_BAR = 4096, CW_CNT = 8192;

constexpr int RING_OFF = 0, RING_BYTES = 131072;
constexpr int LDSCTL_OFF = 143360;
constexpr int TAB_OFF = LDSCTL_OFF + 1024;
constexpr int LDS_BYTES = 147456;

#define GAS __attribute__((address_space(1)))
#define LAS __attribute__((address_space(3)))
typedef unsigned short bf16;
typedef unsigned v4u __attribute__((ext_vector_type(4)));
typedef unsigned v2u __attribute__((ext_vector_type(2)));
using pg8::f32x4; using pg8::f32x2; using pg8::bf16x8;
typedef GAS unsigned gu32;
#define RLX_AGENT __ATOMIC_RELAXED, __HIP_MEMORY_SCOPE_AGENT
#define LDS_WAIT() asm volatile("s_waitcnt lgkmcnt(0)" ::: "memory")
__device__ __forceinline__ unsigned f2bf(float f) { unsigned u = __builtin_bit_cast(unsigned, f); return (u + 0x7fffu + ((u >> 16) & 1u)) >> 16; }
__device__ __forceinline__ unsigned pk2(float lo, float hi) { return f2bf(lo) | (f2bf(hi) << 16); }
__device__ __forceinline__ float bf_lo(unsigned u) { return __builtin_bit_cast(float, u << 16); }
__device__ __forceinline__ float bf_hi(unsigned u) { return __builtin_bit_cast(float, u & 0xffff0000u); }
__device__ __forceinline__ float wave_sum(float v) {
#pragma unroll
    for (int o = 1; o < 64; o <<= 1) v += __shfl_xor(v, o);
    return v;
}
constexpr float SC_H = 16.0f, SC_WGU = 64.0f, SC_HID = 8.0f, SC_WD = 32.0f;
__device__ __forceinline__ unsigned pk4_fp8(float a, float b, float c, float d) {
    a = __builtin_fminf(__builtin_fmaxf(a, -448.0f), 448.0f); b = __builtin_fminf(__builtin_fmaxf(b, -448.0f), 448.0f);
    c = __builtin_fminf(__builtin_fmaxf(c, -448.0f), 448.0f); d = __builtin_fminf(__builtin_fmaxf(d, -448.0f), 448.0f);
    int w = __builtin_amdgcn_cvt_pk_fp8_f32(a, b, 0, false); w = __builtin_amdgcn_cvt_pk_fp8_f32(c, d, w, true); return (unsigned)w; }
#define DPP_STEP(v, ctrl) ((v) + __builtin_bit_cast(float, __builtin_amdgcn_update_dpp(0, __builtin_bit_cast(int, (v)), (ctrl), 0xF, 0xF, true)))
__device__ __forceinline__ float wave_sum_dpp(float v) {
    v = DPP_STEP(v, 0xB1);
    v = DPP_STEP(v, 0x4E);
    v = DPP_STEP(v, 0x141);
    v = DPP_STEP(v, 0x140);
    const int iv = __builtin_bit_cast(int, v);
    const float r0 = __builtin_bit_cast(float, __builtin_amdgcn_readlane(iv, 0)), r1 = __builtin_bit_cast(float, __builtin_amdgcn_readlane(iv, 16));
    const float r2 = __builtin_bit_cast(float, __builtin_amdgcn_readlane(iv, 32)), r3 = __builtin_bit_cast(float, __builtin_amdgcn_readlane(iv, 48));
    return (r0 + r1) + (r2 + r3);
}
__device__ __forceinline__ void wave_sum3_dpp(float& a, float& b, float& c) {
    a = DPP_STEP(a, 0xB1); b = DPP_STEP(b, 0xB1); c = DPP_STEP(c, 0xB1);
    a = DPP_STEP(a, 0x4E); b = DPP_STEP(b, 0x4E); c = DPP_STEP(c, 0x4E);
    a = DPP_STEP(a, 0x141); b = DPP_STEP(b, 0x141); c = DPP_STEP(c, 0x141);
    a = DPP_STEP(a, 0x140); b = DPP_STEP(b, 0x140); c = DPP_STEP(c, 0x140);
    const int ia = __builtin_bit_cast(int, a), ib = __builtin_bit_cast(int, b), ic = __builtin_bit_cast(int, c);
#define RL_(v, l) __builtin_bit_cast(float, __builtin_amdgcn_readlane((v), (l)))
    a = (RL_(ia, 0) + RL_(ia, 16)) + (RL_(ia, 32) + RL_(ia, 48));
    b = (RL_(ib, 0) + RL_(ib, 16)) + (RL_(ib, 32) + RL_(ib, 48));
    c = (RL_(ic, 0) + RL_(ic, 16)) + (RL_(ic, 32) + RL_(ic, 48));
#undef RL_
}
typedef _Float16 f16x2_ __attribute__((ext_vector_type(2)));
typedef _Float16 f16x8_ __attribute__((ext_vector_type(8)));
__device__ __forceinline__ unsigned pkh2(float lo, float hi) { const f16x2_ h = {(_Float16)lo, (_Float16)hi}; return __builtin_bit_cast(unsigned, h); }
__device__ __forceinline__ float h_lo(unsigned u) { return (float)__builtin_bit_cast(f16x2_, u).x; }
__device__ __forceinline__ float h_hi(unsigned u) { return (float)__builtin_bit_cast(f16x2_, u).y; }
__device__ __forceinline__ unsigned cvt2bf(float lo, float hi) { unsigned r; asm volatile("v_cvt_pk_bf16_f32 %0, %1, %2" : "=v"(r) : "v"(lo), "v"(hi)); return r; }
__device__ __forceinline__ float dot4(f32x4 a, f32x4 b) { return (a.x * b.x + a.y * b.y) + (a.z * b.z + a.w * b.w); }

__device__ __forceinline__ int lane_id_fresh() { int l; asm volatile("v_mbcnt_lo_u32_b32 %0, -1, 0\n\tv_mbcnt_hi_u32_b32 %0, -1, %0" : "=v"(l)); return l; }
#define XB_TMO      128
#define XB_XCNT(j)  (256  + 64 * (j))
#define XB_XSUB(j)  (1280 + 64 * (j))
#define XB_XGEN(j)  (2304 + 64 * (j))
#define XB_TOP      3328
#define XB_TOPGEN   3392
#define XCD_BAR_WORDS 3456
#define XB_SPIN_CAP (1u << 22)

__device__ __forceinline__ unsigned xb_ld(unsigned* p)              { return __hip_atomic_load(p, __ATOMIC_RELAXED, __HIP_MEMORY_SCOPE_AGENT); }
__device__ __forceinline__ unsigned xb_add(unsigned* p, unsigned v) { return __hip_atomic_fetch_add(p, v, __ATOMIC_RELAXED, __HIP_MEMORY_SCOPE_AGENT); }
__device__ __forceinline__ unsigned xb_xcc_id() { return (unsigned)__builtin_amdgcn_s_getreg((3 << 11) | 20) & 0xFu; }
#define XB_SPIN(cond, bar) do { unsigned _sp = 0; while (cond) { __builtin_amdgcn_s_sleep(1); \
    if ((++_sp & 255u) == 0u) { if (xb_ld(&(bar)[XB_TMO])) break; if (_sp > XB_SPIN_CAP) { atomicAdd(&(bar)[XB_TMO], 1u); break; } } } } while (0)

struct XcdBarrier { unsigned* bar; unsigned x; volatile LAS unsigned* st; };

__device__ __forceinline__ XcdBarrier xcd_barrier_post(unsigned* bar, volatile LAS unsigned* st) {
    XcdBarrier b; b.bar = bar; b.x = xb_xcc_id(); b.st = st;
    if (threadIdx.x == 0) (void)xb_add(&bar[XB_XCNT(b.x)], 1u);
    return b;
}
__device__ __forceinline__ void xcd_barrier_complete(unsigned* bar, unsigned x, unsigned& nloc, unsigned& nx) {
    const unsigned G = gridDim.x * gridDim.y * gridDim.z;
    unsigned sum, cnt, mine, sp = 0u;
    for (;;) {
        sum = 0u; cnt = 0u; mine = 0u;
#pragma unroll
        for (unsigned j = 0; j < 16; ++j) { const unsigned c = xb_ld(&bar[XB_XCNT(j)]); sum += c; cnt += (c > 0u) ? 1u : 0u; mine = (j == x) ? c : mine; }
        if (sum == G) break;
        __builtin_amdgcn_s_sleep(1);
        if ((++sp & 255u) == 0u) { if (xb_ld(&bar[XB_TMO])) break; if (sp > XB_SPIN_CAP) { atomicAdd(&bar[XB_TMO], 1u); break; } }
    }
    nloc = mine > 0u ? mine : 1u; nx = cnt > 0u ? cnt : 1u;
}
__device__ __forceinline__ void xcd_barrier(const XcdBarrier& b, const int wave_id) {
    asm volatile("s_waitcnt vmcnt(0)" ::: "memory");
    __syncthreads();
    if (wave_id == 0 && lane_id_fresh() == 0) {
        unsigned* bar = b.bar; asm volatile("" : "+s"(bar));
        __builtin_amdgcn_s_waitcnt(0);
        unsigned nloc = b.st[0], nx = b.st[1];
        if (nloc == 0u) { xcd_barrier_complete(bar, b.x, nloc, nx); b.st[0] = nloc; b.st[1] = nx; }
        const unsigned old = xb_add(&bar[XB_XSUB(b.x)], 1u);
        const unsigned gen = old / nloc;
        if (old + 1u == (gen + 1u) * nloc) {
            __builtin_amdgcn_fence(__ATOMIC_RELEASE, "agent");
            asm volatile("s_waitcnt vmcnt(0)" ::: "memory");
            const unsigned og = xb_add(&bar[XB_TOP], 1u);
            const unsigned tg = og / nx;
            if (og + 1u == (tg + 1u) * nx) xb_add(&bar[XB_TOPGEN], 1u);
            else XB_SPIN(xb_ld(&bar[XB_TOPGEN]) == tg, bar);
            __builtin_amdgcn_fence(__ATOMIC_ACQUIRE, "agent");
            xb_add(&bar[XB_XGEN(b.x)], 1u);
            asm volatile("s_waitcnt vmcnt(0)" ::: "memory");
        } else {
            XB_SPIN(xb_ld(&bar[XB_XGEN(b.x)]) == gen, bar);
            __builtin_amdgcn_fence(__ATOMIC_ACQUIRE, "agent");
            asm volatile("s_waitcnt vmcnt(0)" ::: "memory");
        }
    }
    __syncthreads();
}

struct Args {
    const float* in[23]; float* out_; unsigned char* ws;
#define ARGS_IN(name, k) __device__ __forceinline__ const float* name() const { return in[k]; }
    ARGS_IN(x, 0) ARGS_IN(c, 1) ARGS_IN(w_ada, 2) ARGS_IN(b_ada, 3) ARGS_IN(g_pre1, 4) ARGS_IN(g_post1, 5) ARGS_IN(w_in, 6) ARGS_IN(conv_a, 7) ARGS_IN(norm_a, 8)
    ARGS_IN(conv_b, 9) ARGS_IN(conv_b_bias, 10) ARGS_IN(ln_g, 11) ARGS_IN(ln_b, 12) ARGS_IN(w_out, 13) ARGS_IN(g_pre2, 14) ARGS_IN(g_post2, 15) ARGS_IN(w_rg, 16)
    ARGS_IN(b_rg, 17) ARGS_IN(w_re, 18) ARGS_IN(b_re, 19) ARGS_IN(w_eg, 20) ARGS_IN(w_eu, 21) ARGS_IN(w_ed, 22)
#undef ARGS_IN
    __device__ __forceinline__ float* out() const { return out_; }
    __device__ __forceinline__ unsigned* ctl() const { return (unsigned*)(ws + WS_CTL); }
    __device__ __forceinline__ float* mod() const { return (float*)(ws + WS_MOD); }
    __device__ __forceinline__ bf16* WIN() const { return (bf16*)(ws + WS_WIN); }
    __device__ __forceinline__ bf16* WOUT() const { return (bf16*)(ws + WS_WOUT); }
    __device__ __forceinline__ unsigned char* WGU() const { return ws + WS_WGU; }
    __device__ __forceinline__ unsigned char* WD() const { return ws + WS_WD; }
    __device__ __forceinline__ bf16* H() const { return (bf16*)(ws + WS_H); }
    __device__ __forceinline__ bf16* P() const { return (bf16*)(ws + WS_P); }
    __device__ __forceinline__ bf16* Y() const { return (bf16*)(ws + WS_Y); }
    __device__ __forceinline__ bf16* O() const { return (bf16*)(ws + WS_O); }
    __device__ __forceinline__ unsigned char* HID() const { return ws + WS_P; }
    __device__ __forceinline__ unsigned char* H8() const { return ws + WS_H; }
    __device__ __forceinline__ bf16* YD() const { return (bf16*)(ws + WS_Y); }
    __device__ __forceinline__ int* lista() const { return (int*)(ws + WS_LISTA); }
    __device__ __forceinline__ float* listw() const { return (float*)(ws + WS_LISTW); }
    __device__ __forceinline__ bf16* WR() const { return (bf16*)(ws + WS_WR); }
    __device__ __forceinline__ bf16* X1() const { return (bf16*)(ws + WS_X1); }
};
struct Frame { LAS unsigned char* lds; int tid, lane, wave, vcu, G; };
__device__ __forceinline__ Frame phase_frame(const Frame& F0) { Frame F = F0; const int l = lane_id_fresh(); F.lane = l; F.tid = F0.wave * 64 + l; return F; }

__device__ __forceinline__ void p0_ada(const Frame& F, const Args& A) {
    if ((int)blockIdx.x >= 192) return;
    LAS float* sc = (LAS float*)(F.lds + RING_OFF);
    LAS float* red = (LAS float*)(F.lds + RING_OFF + 16384);
    for (int i = F.tid; i < 2 * DM; i += NWAVES * 64) { const int b = i >> 11, k = i & (DM - 1); const float cv = A.c()[b * DM + k]; sc[k * 2 + b] = cv / (1.0f + expf(-cv)); }
    __syncthreads();
    for (int it = blockIdx.x; it < 192; it += F.G) {
        const int k0 = F.wave * 256;
        const float* wp = A.w_ada() + (size_t)k0 * NMODC + it * 64 + F.lane;
        float a0 = 0.f, a1 = 0.f;
        for (int kk = 0; kk < 256; kk += 64) {
            float wv[64];
#pragma unroll
            for (int k = 0; k < 64; ++k) wv[k] = wp[(size_t)(kk + k) * NMODC];
#pragma unroll
            for (int k = 0; k < 64; ++k) { const f32x2 s = *(const LAS f32x2*)(sc + (k0 + kk + k) * 2); a0 += s.x * wv[k]; a1 += s.y * wv[k]; }
        }
        red[(F.wave * 2 + 0) * 64 + F.lane] = a0; red[(F.wave * 2 + 1) * 64 + F.lane] = a1;
        __syncthreads();
        if (F.tid < 128) { const int b = F.tid >> 6, l = F.tid & 63; float s = 0.f;
#pragma unroll
            for (int w = 0; w < 8; ++w) s += red[(w * 2 + b) * 64 + l];
            A.mod()[b * NMODC + it * 64 + l] = s + A.b_ada()[it * 64 + l]; }
        __syncthreads();
    }
}
__host__ __device__ __forceinline__ int inproj_row(int n0) {
    if (n0 < 1024) return n0;
    const int seg = (n0 - 1024) >> 10, off = (n0 - 1024) & 1023, j = off >> 7, r = off & 127;
    return (seg < 2 ? 1024 : 3072) + 256 * j + 128 * (seg & 1) + r;
}
__device__ __forceinline__ void transpose_item_bf16(const float* W, int N, int k0, int n0, bf16* dst, int ldk, LAS float* scr, int lane) {
    float tv[32];
    { const float* wp = W + (size_t)(k0 + (lane >> 5)) * N + n0 + (lane & 31);
#pragma unroll
      for (int i = 0; i < 32; ++i) tv[i] = wp[(size_t)(2 * i) * N]; }
#pragma unroll
    for (int i = 0; i < 32; ++i) scr[(2 * i + (lane >> 5)) * 33 + (lane & 31)] = tv[i];
    LDS_WAIT(); asm volatile("" ::: "memory");
    const int c = lane & 7;
#pragma unroll
    for (int j = 0; j < 4; ++j) { const int n = (lane >> 3) + 8 * j; const LAS float* sp = scr + (8 * c) * 33 + n;
        v4u o; o.x = pk2(sp[0 * 33], sp[1 * 33]); o.y = pk2(sp[2 * 33], sp[3 * 33]); o.z = pk2(sp[4 * 33], sp[5 * 33]); o.w = pk2(sp[6 * 33], sp[7 * 33]);
        *(v4u*)(dst + (size_t)n * ldk + 8 * c) = o; }
    LDS_WAIT(); asm volatile("" ::: "memory");
}
__device__ __forceinline__ void p0_router_weights(const Frame& F, const Args& A) {
    const int gt = F.vcu * NWAVES * 64 + F.tid, NGT = F.G * NWAVES * 64;
    for (int it = gt; it < 8 * 8 * 5 * 64; it += NGT) {
        const int l = it & 63, nf = (it >> 6) % 5, wc = it / 320, c = wc & 7, w = wc >> 3;
        const int n = 16 * nf + (l & 15), kg = l >> 4;
        float v[8];
#pragma unroll
        for (int j = 0; j < 8; ++j) { const int k = 256 * w + 64 * (c >> 1) + 16 * kg + 8 * (c & 1) + j;
            v[j] = n < 8 ? A.w_rg()[k * 8 + n] : (n < 72 ? A.w_re()[((size_t)((n - 8) >> 3) * DM + k) * 8 + ((n - 8) & 7)] : 0.f); }
        v4u* dst = (v4u*)A.WR() + (size_t)((w * 8 + c) * 5 + nf) * 64 + l;
        dst[0] = (v4u){pkh2(v[0], v[1]), pkh2(v[2], v[3]), pkh2(v[4], v[5]), pkh2(v[6], v[7])};
    }
}
constexpr int P0X_ITEMS = 3 * NEXP * 64;
struct XItem { const float* src; unsigned char* dst; int N; float scale; };
__device__ __forceinline__ XItem p0x_item(const Args& A, int it, int w) {
    XItem t; const int mat = it / (NEXP * 64), r = it - mat * (NEXP * 64), e = r >> 6, rr = r & 63;
    if (mat < 2) { const int kt = rr >> 2, nb = rr & 3; t.N = DEXP; t.scale = SC_WGU;
        t.src = (mat ? A.w_eu() : A.w_eg()) + (size_t)e * DM * DEXP + (size_t)(128 * kt) * DEXP + 256 * nb;
        const int nn = 32 * w, drow = 256 * (2 * nb + (nn >> 7)) + 128 * mat + (nn & 127);
        t.dst = A.WGU() + ((size_t)(e * 16 + kt) * 2048 + drow) * 128; }
    else { const int kt = rr >> 3, nb = rr & 7; t.N = DM; t.scale = SC_WD;
        t.src = A.w_ed() + (size_t)e * DEXP * DM + (size_t)(128 * kt) * DM + 256 * nb;
        t.dst = A.WD() + ((size_t)(e * 8 + kt) * 2048 + 256 * nb + 32 * w) * 128; }
    return t;
}
__device__ __forceinline__ void p0x_load(const XItem& t, int w, int lane, f32x4 (&v)[16]) {
    const f32x4* p = (const f32x4*)(t.src + (size_t)(16 * w) * t.N) + lane;
#pragma unroll
    for (int j = 0; j < 16; ++j) v[j] = __builtin_nontemporal_load((const f32x4*)((const float*)p + (size_t)j * t.N));
}
#define XW_BAR() do { LDS_WAIT(); __builtin_amdgcn_s_barrier(); asm volatile("" ::: "memory"); } while (0)
__device__ __forceinline__ void xw_put(LAS float* tile, int w, int lane, const f32x4 (&v)[16]) {
#pragma unroll
    for (int j = 0; j < 16; ++j) *(LAS f32x4*)(tile + (16 * w + j) * 260 + 4 * lane) = v[j];
}
__device__ __forceinline__ void xw_emit(const LAS float* tile, const XItem& cur, int w, int lane) {
    const int n = lane & 31, kh = lane >> 5; const float sc = cur.scale;
    const LAS float* col = tile + 32 * w + n;
#pragma unroll
    for (int q = 0; q < 4; ++q) { const LAS float* sp = col + (32 * q + 16 * kh) * 260;
        v4u o;
        o.x = pk4_fp8(sp[0 * 260] * sc, sp[1 * 260] * sc, sp[2 * 260] * sc, sp[3 * 260] * sc);     o.y = pk4_fp8(sp[4 * 260] * sc, sp[5 * 260] * sc, sp[6 * 260] * sc, sp[7 * 260] * sc);
        o.z = pk4_fp8(sp[8 * 260] * sc, sp[9 * 260] * sc, sp[10 * 260] * sc, sp[11 * 260] * sc);   o.w = pk4_fp8(sp[12 * 260] * sc, sp[13 * 260] * sc, sp[14 * 260] * sc, sp[15 * 260] * sc);
        *(v4u*)(cur.dst + (size_t)n * 128 + 32 * q + 16 * kh) = o; }
}
__device__ __forceinline__ void xw_put8(LAS unsigned* tile, int w, int lane, const f32x4 (&v)[16], float sc) {
#pragma unroll
    for (int j = 0; j < 16; ++j) tile[(16 * w + j) * 65 + lane] = pk4_fp8(v[j].x * sc, v[j].y * sc, v[j].z * sc, v[j].w * sc);
}
__device__ __forceinline__ void xw_emit8(const LAS unsigned* tile, unsigned char* dst, int w, int lane) {
    const int g = lane & 7, kc = lane >> 3;
    const LAS unsigned* col = tile + (16 * kc) * 65 + 8 * w + g;
    unsigned o[4][4];
#pragma unroll
    for (int b4 = 0; b4 < 4; ++b4) { const unsigned d0 = col[(4 * b4 + 0) * 65], d1 = col[(4 * b4 + 1) * 65], d2 = col[(4 * b4 + 2) * 65], d3 = col[(4 * b4 + 3) * 65];
        const unsigned t01l = __builtin_amdgcn_perm(d1, d0, 0x05010400u), t01h = __builtin_amdgcn_perm(d1, d0, 0x07030602u);
        const unsigned t23l = __builtin_amdgcn_perm(d3, d2, 0x05010400u), t23h = __builtin_amdgcn_perm(d3, d2, 0x07030602u);
        o[0][b4] = __builtin_amdgcn_perm(t23l, t01l, 0x05040100u); o[1][b4] = __builtin_amdgcn_perm(t23l, t01l, 0x07060302u);
        o[2][b4] = __builtin_amdgcn_perm(t23h, t01h, 0x05040100u); o[3][b4] = __builtin_amdgcn_perm(t23h, t01h, 0x07060302u); }
#pragma unroll
    for (int j = 0; j < 4; ++j) *(v4u*)(dst + (size_t)(4 * g + j) * 128 + 16 * kc) = (v4u){o[j][0], o[j][1], o[j][2], o[j][3]};
}
template <class T> __device__ __forceinline__ T* uniform_ptr(T* p) {
    const unsigned long long v = (unsigned long long)p; const unsigned lo = (unsigned)__builtin_amdgcn_readfirstlane((int)(unsigned)v), hi = (unsigned)__builtin_amdgcn_readfirstlane((int)(unsigned)(v >> 32));
    return (T*)(((unsigned long long)hi << 32) | lo);
}
__device__ __forceinline__ void xq_issue(const unsigned* ctl, unsigned& cl, unsigned& sv) {
    asm volatile("s_nop 4\n\tglobal_atomic_add %0, %2, %3, %4 offset:256 sc0\n\tglobal_load_dword %1, %2, %4 offset:512 sc1" : "=&v"(cl), "=&v"(sv) : "v"(0u), "v"(1u), "s"(ctl) : "memory");
}
static_assert(CW_Q * 4 == 256 && CW_DONE * 4 == 512, "xq_issue hard-codes the byte offsets of the queue and stop words");
__device__ __forceinline__ void expert_worker(const Frame& F, const Args& A, const unsigned stop_target) {
    LAS unsigned* tile0 = (LAS unsigned*)(F.lds + RING_OFF); LAS unsigned* tile1 = tile0 + 128 * 65; LAS unsigned* tile2 = tile1 + 128 * 65;
    volatile LAS int* qs = (volatile LAS int*)(F.lds + LDSCTL_OFF + 64);
    const int w = F.wave, lane = F.lane;
    const unsigned* ctl = uniform_ptr(A.ctl());
    if (F.tid == 0) {
        const bool stop = stop_target != 0u && __hip_atomic_load(ctl + CW_DONE, RLX_AGENT) >= stop_target;
        const int base = stop ? P0X_ITEMS : (int)__hip_atomic_fetch_add(A.ctl() + CW_Q, 4u, RLX_AGENT);
        qs[0] = base; qs[1] = base + 1; qs[2] = base + 2; qs[3] = base + 3; }
    __syncthreads();
    int i0 = qs[0], i1 = qs[1], i2 = qs[2], i3 = qs[3];
    if (i0 >= P0X_ITEMS) return;
    unsigned cl = 0u, sv = 0u; bool pend = (F.wave == 0) && i3 < P0X_ITEMS, stopped = false;
    if (pend && lane == 0) xq_issue(ctl, cl, sv);
    XItem c0 = p0x_item(A, i0, w), c1 = p0x_item(A, i1 < P0X_ITEMS ? i1 : i0, w), c2 = p0x_item(A, i2 < P0X_ITEMS ? i2 : i0, w); f32x4 va[16], vb[16], vc[16];
    p0x_load(c0, w, lane, va); p0x_load(c1, w, lane, vb); p0x_load(c2, w, lane, vc);
#define XW_CLAIM(slot) do { if (F.wave == 0) { int _n = P0X_ITEMS; \
        if (pend) { asm volatile("s_waitcnt vmcnt(16)" ::: "memory"); asm volatile("" : "+v"(cl), "+v"(sv)); _n = __builtin_amdgcn_readfirstlane((int)cl); \
            if (stop_target != 0u && (unsigned)__builtin_amdgcn_readfirstlane((int)sv) >= stop_target) stopped = true; } \
        if (lane == 0) qs[slot] = _n; \
        pend = !stopped && _n < P0X_ITEMS; \
        if (pend && lane == 0) xq_issue(ctl, cl, sv); } } while (0)
    for (;;) {
        xw_put8(tile0, w, lane, va, c0.scale);
        XW_CLAIM(0);
        XW_BAR();
        const XItem cA = p0x_item(A, i3 < P0X_ITEMS ? i3 : i0, w);
        p0x_load(cA, w, lane, va);
        xw_emit8(tile0, c0.dst, w, lane);
        if (i1 >= P0X_ITEMS) break;
        const int n0 = qs[0];
        xw_put8(tile1, w, lane, vb, c1.scale);
        XW_CLAIM(1);
        XW_BAR();
        const XItem cB = p0x_item(A, n0 < P0X_ITEMS ? n0 : i1, w);
        p0x_load(cB, w, lane, vb);
        xw_emit8(tile1, c1.dst, w, lane);
        if (i2 >= P0X_ITEMS) break;
        const int n1 = qs[1];
        xw_put8(tile2, w, lane, vc, c2.scale);
        XW_CLAIM(2);
        XW_BAR();
        const XItem cC = p0x_item(A, n1 < P0X_ITEMS ? n1 : i2, w);
        p0x_load(cC, w, lane, vc);
        xw_emit8(tile2, c2.dst, w, lane);
        if (i3 >= P0X_ITEMS) break;
        i0 = i3; c0 = cA; i1 = n0; c1 = cB; i2 = n1; c2 = cC; i3 = qs[2];
    }
    XW_BAR();
#undef XW_CLAIM
}
__device__ __forceinline__ void p0_weights(const Frame& F, const Args& A) {
    LAS float* scr = (LAS float*)(F.lds + RING_OFF + F.wave * 16896);
    const int gw = F.vcu * NWAVES + F.wave, NGW = F.G * NWAVES;
    constexpr int I_IN = 32 * 160, I_OUT = 32 * 64;
    for (int it = gw; it < I_IN + I_OUT; it += NGW) {
        if (it < I_IN) { const int kb = it / 160, nb = it % 160, n0 = 32 * nb; transpose_item_bf16(A.w_in(), DINP, 64 * kb, n0, A.WIN() + (size_t)inproj_row(n0) * DM + 64 * kb, DM, scr, F.lane); }
        else { const int r = it - I_IN, kb = r / 64, nb = r % 64, n0 = 32 * nb; transpose_item_bf16(A.w_out(), DM, 64 * kb, n0, A.WOUT() + (size_t)n0 * DM + 64 * kb, DM, scr, F.lane); }
    }
}

__device__ __forceinline__ void p1_norm1(const Frame& F, const Args& A) {
    const int gw = F.vcu * NWAVES + F.wave, NGW = F.G * NWAVES;
    f32x4 a1[8], sh[8]; int bcur = -1;
    for (int m0 = gw; m0 < NTOK; m0 += 2 * NGW) {
        const int m1 = m0 + NGW; const bool has1 = (m1 < NTOK) && ((m1 >> 14) == (m0 >> 14));
        const f32x4* xr0 = (const f32x4*)(A.x() + (size_t)m0 * DM) + 2 * F.lane;
        const f32x4* xr1 = (const f32x4*)(A.x() + (size_t)(has1 ? m1 : m0) * DM) + 2 * F.lane;
        f32x4 v0[8], v1[8];
#pragma unroll
        for (int j = 0; j < 4; ++j) { v0[2 * j] = xr0[128 * j]; v0[2 * j + 1] = xr0[128 * j + 1]; v1[2 * j] = xr1[128 * j]; v1[2 * j + 1] = xr1[128 * j + 1]; }
        if ((m0 >> 14) != bcur) { bcur = m0 >> 14;
            const f32x4* g = (const f32x4*)A.g_pre1() + 2 * F.lane; const f32x4* shp = (const f32x4*)(A.mod() + bcur * NMODC) + 2 * F.lane; const f32x4* scp = (const f32x4*)(A.mod() + bcur * NMODC + DM) + 2 * F.lane;
#pragma unroll
            for (int j = 0; j < 4; ++j) { a1[2 * j] = g[128 * j] * (scp[128 * j] + 1.0f); a1[2 * j + 1] = g[128 * j + 1] * (scp[128 * j + 1] + 1.0f); sh[2 * j] = shp[128 * j]; sh[2 * j + 1] = shp[128 * j + 1]; } }
        float s0 = 0.f, s1 = 0.f;
#pragma unroll
        for (int j = 0; j < 8; ++j) { s0 += dot4(v0[j], v0[j]); s1 += dot4(v1[j], v1[j]); }
        const float r0 = 1.0f / sqrtf(wave_sum(s0) * (1.0f / DM) + EPS), r1 = 1.0f / sqrtf(wave_sum(s1) * (1.0f / DM) + EPS);
        { v4u* o16 = (v4u*)(A.H() + (size_t)m0 * DM) + F.lane;
#pragma unroll
          for (int j = 0; j < 4; ++j) { const f32x4 ha = v0[2 * j] * r0 * a1[2 * j] + sh[2 * j], hb = v0[2 * j + 1] * r0 * a1[2 * j + 1] + sh[2 * j + 1];
              o16[64 * j] = (v4u){pg8::cvt_pk_bf16(ha.x, ha.y), pg8::cvt_pk_bf16(ha.z, ha.w), pg8::cvt_pk_bf16(hb.x, hb.y), pg8::cvt_pk_bf16(hb.z, hb.w)}; } }
        if (has1) { v4u* o16 = (v4u*)(A.H() + (size_t)m1 * DM) + F.lane;
#pragma unroll
          for (int j = 0; j < 4; ++j) { const f32x4 ha = v1[2 * j] * r1 * a1[2 * j] + sh[2 * j], hb = v1[2 * j + 1] * r1 * a1[2 * j + 1] + sh[2 * j + 1];
              o16[64 * j] = (v4u){pg8::cvt_pk_bf16(ha.x, ha.y), pg8::cvt_pk_bf16(ha.z, ha.w), pg8::cvt_pk_bf16(hb.x, hb.y), pg8::cvt_pk_bf16(hb.z, hb.w)}; } }
        else if (m1 < NTOK) { m0 -= NGW; }
    }
}

__device__ __forceinline__ float sigmoidf_(float v) { return __builtin_amdgcn_rcpf(1.0f + __expf(-v)); }
constexpr size_t OTILE_PITCH = 65536 + 128;
struct EpiStoreFrag {
    static constexpr bool PERM = true, AFTER_DRAIN = false;
    bf16* O; int ntn;
    __device__ __forceinline__ void operator()(const pg8::f32x4 (&acc)[2][2][4][2], const pg8::Unit& u, int wr, int wc, int fr, int fq) const {
        bf16* base = O + ((size_t)(u.pm * ntn + u.pn) * OTILE_PITCH) + (size_t)((wr * 4 + wc) * 16) * 512 + (fq * 16 + fr) * 8;
#pragma unroll
        for (int ai = 0; ai < 2; ++ai)
#pragma unroll
            for (int m = 0; m < 4; ++m)
#pragma unroll
                for (int bj = 0; bj < 2; ++bj) { const pg8::f32x4 v0 = acc[ai][bj][m][0], v1 = acc[ai][bj][m][1];
                    v4u w; w.x = pg8::cvt_pk_bf16(v0[0], v0[1]); w.y = pg8::cvt_pk_bf16(v0[2], v0[3]); w.z = pg8::cvt_pk_bf16(v1[0], v1[1]); w.w = pg8::cvt_pk_bf16(v1[2], v1[3]);
                    __builtin_nontemporal_store(w, (v4u*)(base + ((ai * 4 + m) * 2 + bj) * 512)); }
    }
};
struct EpiInProj {
    static constexpr bool PERM = true, AFTER_DRAIN = false;
    bf16* P;
    __device__ __forceinline__ void operator()(const pg8::f32x4 (&acc)[2][2][4][2], const pg8::Unit& u, int wr, int wc, int fr, int fq) const {
        unsigned char* pmb = (unsigned char*)P + (size_t)u.pm * 1572864; const int rowt = wr * 64 + fr;
        if (u.pn < 4) {
            unsigned char* tb = pmb + u.pn * 131072 + (wc * 32 + 8 * fq) * 2;
#pragma unroll
            for (int ai = 0; ai < 2; ++ai)
#pragma unroll
                for (int m = 0; m < 4; ++m) { unsigned char* rowp = tb + (size_t)(rowt + ai * 128 + m * 16) * 512;
#pragma unroll
                    for (int bj = 0; bj < 2; ++bj) { const pg8::f32x4 v0 = acc[ai][bj][m][0], v1 = acc[ai][bj][m][1];
                        v4u w; w.x = pg8::cvt_pk_bf16(v0[0], v0[1]); w.y = pg8::cvt_pk_bf16(v0[2], v0[3]); w.z = pg8::cvt_pk_bf16(v1[0], v1[1]); w.w = pg8::cvt_pk_bf16(v1[2], v1[3]);
                        __builtin_nontemporal_store(w, (v4u*)(rowp + bj * 256)); } }
        } else {
            const bool glu = u.pn >= 12;
            unsigned char* tb = pmb + (glu ? 1048576 + (u.pn - 12) * 65536 : 524288 + (u.pn - 4) * 65536) + (wc * 32 + 8 * fq) * 2;
#pragma unroll
            for (int ai = 0; ai < 2; ++ai)
#pragma unroll
                for (int m = 0; m < 4; ++m) { unsigned char* rowp = tb + (size_t)(rowt + ai * 128 + m * 16) * 256;
                    pg8::f32x4 a0 = acc[ai][0][m][0], a1 = acc[ai][0][m][1]; const pg8::f32x4 b0 = acc[ai][1][m][0], b1 = acc[ai][1][m][1];
                    if (glu) {
#pragma unroll
                        for (int i = 0; i < 4; ++i) { a0[i] *= sigmoidf_(b0[i]); a1[i] *= sigmoidf_(b1[i]); }
                    } else { a0 = a0 * b0; a1 = a1 * b1; }
                    v4u w; w.x = pg8::cvt_pk_bf16(a0[0], a0[1]); w.y = pg8::cvt_pk_bf16(a0[2], a0[3]); w.z = pg8::cvt_pk_bf16(a1[0], a1[1]); w.w = pg8::cvt_pk_bf16(a1[2], a1[3]);
                    __builtin_nontemporal_store(w, (v4u*)rowp); }
        }
    }
};

__device__ __forceinline__ void p3_mix(const Frame& F, const Args& A) {
    LAS float* stats = (LAS float*)(F.lds + RING_OFF);
    LAS float* fin = (LAS float*)(F.lds + RING_OFF + 4096);
    const int tid = F.tid, ch = 2 * tid;
    float ca[3][2]; f32x2 cb[31];
#pragma unroll
    for (int k = 0; k < 3; ++k) { ca[k][0] = A.conv_a()[k * DCA + ch]; ca[k][1] = A.conv_a()[k * DCA + ch + 1]; }
#pragma unroll
    for (int k = 0; k < 31; ++k) cb[k] = (f32x2){A.conv_b()[k * DCA + ch], A.conv_b()[k * DCA + ch + 1]};
    const float na0 = A.norm_a()[ch], na1 = A.norm_a()[ch + 1], bb0 = A.conv_b_bias()[ch], bb1 = A.conv_b_bias()[ch + 1];
    const float lg0 = A.ln_g()[ch], lg1 = A.ln_g()[ch + 1], lb0 = A.ln_b()[ch], lb1 = A.ln_b()[ch + 1];
    const __amdgpu_buffer_rsrc_t Prs = __builtin_amdgcn_make_buffer_rsrc((void*)A.P(), 0, (int)((size_t)NTOK * PW * 2), 0x00020000);
    const __amdgpu_buffer_rsrc_t Yrs = __builtin_amdgcn_make_buffer_rsrc((void*)A.Y(), 0, (int)((size_t)NTOK * DM * 2), 0x00020000);
    const int vo = 4 * tid;
    const int voB = (tid >> 7) * 131072 + 4 * (tid & 127), voC = 524288 + (tid >> 6) * 65536 + 4 * (tid & 63), voU = voC + 524288;
#define P3_LDB(t) __builtin_amdgcn_raw_buffer_load_b32(Prs, voB, ((t) >> 8) * 1572864 + ((t) & 255) * 512, 0)
#define P3_LDC(t) __builtin_amdgcn_raw_buffer_load_b32(Prs, voC, ((t) >> 8) * 1572864 + ((t) & 255) * 256, 0)
#define P3_LDU(t) __builtin_amdgcn_raw_buffer_load_b32(Prs, voU, ((t) >> 8) * 1572864 + ((t) & 255) * 256, 0)
#define P3_ST(v, t, cb_) __builtin_amdgcn_raw_buffer_store_b32((v), Yrs, vo, (t) * 4096 + (cb_), 0)
    for (int tile = blockIdx.x; tile < NTOK / 128; tile += F.G) {
        const int t0 = tile * 128; const bool first = (t0 & (SEQ - 1)) == 0;
        f32x2 wb[32];
        wb[0] = (f32x2){0.f, 0.f}; wb[1] = (f32x2){0.f, 0.f};
#pragma unroll
        for (int s = 2; s < 32; ++s) { unsigned uu = 0u; if (!first) uu = P3_LDU(t0 - 32 + s); wb[s] = (f32x2){bf_lo(uu), bf_hi(uu)}; }
        float cm1[2], cm2[2];
        { unsigned u1 = 0u, u2 = 0u; if (!first) { u1 = P3_LDC(t0 - 1); u2 = P3_LDC(t0 - 2); }
          cm1[0] = bf_lo(u1); cm1[1] = bf_hi(u1); cm2[0] = bf_lo(u2); cm2[1] = bf_hi(u2); }
        unsigned nb[8], nc[8], nu[8];
#pragma unroll
        for (int s = 0; s < 8; ++s) { nb[s] = P3_LDB(t0 + s); nc[s] = P3_LDC(t0 + s); nu[s] = P3_LDU(t0 + s); }
        for (int blk = 0; blk < 4; ++blk) {
#pragma unroll
            for (int sub = 0; sub < 4; ++sub) {
                const int par = sub & 1;
                const int tb = t0 + 32 * blk + 8 * sub;
                unsigned pb[8], pc[8], pu[8];
#pragma unroll
                for (int s = 0; s < 8; ++s) { pb[s] = nb[s]; pc[s] = nc[s]; pu[s] = nu[s]; }
#pragma unroll
                for (int s = 0; s < 8; ++s) { nb[s] = P3_LDB(tb + 8 + s); nc[s] = P3_LDC(tb + 8 + s); nu[s] = P3_LDU(tb + 8 + s); }
                float vk[8][2];
#pragma unroll
                for (int s = 0; s < 8; ++s) {
                    const int S = 8 * sub + s;
                    const float c0 = bf_lo(pc[s]), c1 = bf_hi(pc[s]);
                    const float ya0 = bf_lo(pb[s]) * (ca[0][0] * cm2[0] + ca[1][0] * cm1[0] + ca[2][0] * c0);
                    const float ya1 = bf_hi(pb[s]) * (ca[0][1] * cm2[1] + ca[1][1] * cm1[1] + ca[2][1] * c1);
                    cm2[0] = cm1[0]; cm2[1] = cm1[1]; cm1[0] = c0; cm1[1] = c1;
                    wb[S] = (f32x2){bf_lo(pu[s]), bf_hi(pu[s])};
                    f32x2 av = (f32x2){bb0, bb1}, aw = (f32x2){0.f, 0.f};
#pragma unroll
                    for (int k = 0; k < 30; k += 2) { av = __builtin_elementwise_fma(cb[k], wb[(S + 2 + k) & 31], av); aw = __builtin_elementwise_fma(cb[k + 1], wb[(S + 3 + k) & 31], aw); }
                    av = __builtin_elementwise_fma(cb[30], wb[S], av) + aw;
                    const float a0 = av.x, a1 = av.y;
                    vk[s][0] = a0; vk[s][1] = a1;
                    float ssa = ya0 * ya0 + ya1 * ya1, s1 = a0 + a1, s2 = a0 * a0 + a1 * a1;
                    wave_sum3_dpp(ssa, s1, s2);
                    const float ra = __builtin_amdgcn_rsqf(ssa * (1.0f / 128.0f) + EPS);
                    P3_ST(cvt2bf(ya0 * ra * na0, ya1 * ra * na1), tb + s, 0);
                    if (F.lane == 0) { stats[((par * 8 + s) * 8 + F.wave) * 2 + 0] = s1; stats[((par * 8 + s) * 8 + F.wave) * 2 + 1] = s2; }
                }
                LDS_WAIT(); __builtin_amdgcn_s_barrier(); asm volatile("" ::: "memory");
                if (tid < 8) { float q1 = 0.f, q2 = 0.f;
#pragma unroll
                    for (int w = 0; w < 8; ++w) { q1 += stats[((par * 8 + tid) * 8 + w) * 2 + 0]; q2 += stats[((par * 8 + tid) * 8 + w) * 2 + 1]; }
                    const float mean = q1 * (1.0f / 1024.0f); float var = q2 * (1.0f / 1024.0f) - mean * mean; var = var > 0.f ? var : 0.f;
                    fin[(par * 8 + tid) * 2 + 0] = mean; fin[(par * 8 + tid) * 2 + 1] = __builtin_amdgcn_rsqf(var + EPS); }
                LDS_WAIT(); __builtin_amdgcn_s_barrier(); asm volatile("" ::: "memory");
#pragma unroll
                for (int s = 0; s < 8; ++s) { const float mean = fin[(par * 8 + s) * 2 + 0], rstd = fin[(par * 8 + s) * 2 + 1];
                    const float z0 = (vk[s][0] - mean) * rstd * lg0 + lb0, z1 = (vk[s][1] - mean) * rstd * lg1 + lb1;
                    P3_ST(cvt2bf(z0 * sigmoidf_(z0), z1 * sigmoidf_(z1)), tb + s, 2048); }
            }
        }
    }
#undef P3_LDB
#undef P3_LDC
#undef P3_LDU
#undef P3_ST
}

constexpr int P5_OFF_PV = 0;
constexpr int P5_OFF_RED = 24576;
constexpr int P5_OFF_PART = 25600;
constexpr int P5_OFF_LOG = 66560;
constexpr int P5_OFF_REC = 71680;
constexpr int P5_OFF_CNT = 88064;
constexpr int P5_MAXREC = 1024;
__device__ __forceinline__ void p5_params(const Frame& F, const Args& A, int b) {
    LAS float* pv = (LAS float*)(F.lds + RING_OFF + P5_OFF_PV); const float* modb = A.mod() + b * NMODC;
    for (int k = F.tid; k < DM; k += NWAVES * 64) { pv[k] = modb[2 * DM + k] * A.g_post1()[k]; pv[DM + k] = A.g_pre2()[k] * (modb[4 * DM + k] + 1.0f); pv[2 * DM + k] = modb[3 * DM + k]; }
}
#define P5_BAR() do { LDS_WAIT(); __builtin_amdgcn_s_barrier(); asm volatile("" ::: "memory"); } while (0)
__device__ __forceinline__ void p5_norm2_router(const Frame& F, const Args& A) {
    const int lane = F.lane, w = F.wave, r = lane & 15, q = lane >> 4, kb = 256 * w, ko = kb + 16 * q;
    LAS float* pv = (LAS float*)(F.lds + RING_OFF + P5_OFF_PV);
    LAS float* red1 = (LAS float*)(F.lds + RING_OFF + P5_OFF_RED); LAS float* red2 = red1 + 128;
    LAS float* part = (LAS float*)(F.lds + RING_OFF + P5_OFF_PART);
    LAS float* lg = (LAS float*)(F.lds + RING_OFF + P5_OFF_LOG);
    LAS int* rec_e = (LAS int*)(F.lds + RING_OFF + P5_OFF_REC); LAS int* rec_a = rec_e + P5_MAXREC; LAS int* rec_p = rec_a + P5_MAXREC; LAS float* rec_w = (LAS float*)(rec_p + P5_MAXREC);
    LAS int* lcnt = (LAS int*)(F.lds + RING_OFF + P5_OFF_CNT); LAS int* lbase = lcnt + 64;
    if (F.tid < 64) lcnt[F.tid] = 0;
    const int tpb = (NTOK / 16 + F.G - 1) / F.G;
    int bcur = -1, nrec = 0;
    for (int i = 0; i < tpb; ++i) {
        const int tile = (int)blockIdx.x * tpb + i; if (tile >= NTOK / 16) break;
        const int mt0 = tile * 16, b = mt0 >> 14, m = mt0 + r;
        const float* xrow = A.x() + (size_t)m * DM + ko;
        const int oidx = (mt0 >> 4) & 15;
        const bf16* otile = A.O() + (size_t)((mt0 >> 8) * 8 + w) * OTILE_PITCH + (size_t)(((oidx >> 2) & 1) * 64 * 512) + (size_t)(((oidx >> 3) * 4 + (oidx & 3)) * 2) * 512 + (size_t)r * 8;
        f32x4 xv[4][4]; v4u ov[4][2];
#pragma unroll
        for (int cg = 0; cg < 4; ++cg) {
#pragma unroll
            for (int j = 0; j < 4; ++j) xv[cg][j] = *(const f32x4*)(xrow + 64 * cg + 4 * j);
#pragma unroll
            for (int hh = 0; hh < 2; ++hh) { const int wcq = (2 * cg + (q >> 1)) & 3, fqq = 2 * (q & 1) + hh;
                ov[cg][hh] = *(const v4u*)(otile + (size_t)(wcq * 16 + (cg >> 1)) * 512 + fqq * 128); } }
        if (b != bcur) { P5_BAR(); p5_params(F, A, b); bcur = b; P5_BAR(); }
        float so = 0.f;
#pragma unroll
        for (int cg = 0; cg < 4; ++cg)
#pragma unroll
            for (int hh = 0; hh < 2; ++hh) { const v4u p = ov[cg][hh]; const f32x4 va = (f32x4){bf_lo(p.x), bf_hi(p.x), bf_lo(p.y), bf_hi(p.y)}, vb = (f32x4){bf_lo(p.z), bf_hi(p.z), bf_lo(p.w), bf_hi(p.w)};
                so += dot4(va, va) + dot4(vb, vb); }
        so += __shfl_xor(so, 16); so += __shfl_xor(so, 32);
        if (q == 0) red1[w * 16 + r] = so;
        P5_BAR();
        float to = 0.f;
#pragma unroll
        for (int ww = 0; ww < 8; ++ww) to += red1[ww * 16 + r];
        const float ro = 1.0f / sqrtf(to * (1.0f / DM) + EPS);
        bf16* x1row = A.X1() + (size_t)m * DM + ko; float sx = 0.f;
#pragma unroll
        for (int cg = 0; cg < 4; ++cg)
#pragma unroll
            for (int hh = 0; hh < 2; ++hh) { const v4u p = ov[cg][hh]; const f32x4 va = (f32x4){bf_lo(p.x), bf_hi(p.x), bf_lo(p.y), bf_hi(p.y)}, vb = (f32x4){bf_lo(p.z), bf_hi(p.z), bf_lo(p.w), bf_hi(p.w)};
                const f32x4 a1a = *(const LAS f32x4*)(pv + ko + 64 * cg + 8 * hh), a1b = *(const LAS f32x4*)(pv + ko + 64 * cg + 8 * hh + 4);
                const f32x4 x1a = xv[cg][2 * hh] + a1a * (va * ro), x1b = xv[cg][2 * hh + 1] + a1b * (vb * ro);
                xv[cg][2 * hh] = x1a; xv[cg][2 * hh + 1] = x1b;
                *(v4u*)(x1row + 64 * cg + 8 * hh) = (v4u){cvt2bf(x1a.x, x1a.y), cvt2bf(x1a.z, x1a.w), cvt2bf(x1b.x, x1b.y), cvt2bf(x1b.z, x1b.w)}; sx += dot4(x1a, x1a) + dot4(x1b, x1b); }
        sx += __shfl_xor(sx, 16); sx += __shfl_xor(sx, 32);
        if (q == 0) red2[w * 16 + r] = sx;
        P5_BAR();
        float tx = 0.f;
#pragma unroll
        for (int ww = 0; ww < 8; ++ww) tx += red2[ww * 16 + r];
        const float r1 = 1.0f / sqrtf(tx * (1.0f / DM) + EPS);
        unsigned char* hrow = A.H8() + (size_t)m * DM + ko;
        const __amdgpu_buffer_rsrc_t wrs = __builtin_amdgcn_make_buffer_rsrc((void*)A.WR(), 0, 8 * 8 * 5 * 1024, 0x00020000);
#define P5_LDB(c, f) __builtin_bit_cast(f16x8_, __builtin_amdgcn_raw_buffer_load_b128(wrs, lane * 16, ((w * 8 + (c)) * 5 + (f)) * 1024, 0))
        f32x4 acc[5];
#pragma unroll
        for (int nf = 0; nf < 5; ++nf) acc[nf] = (f32x4){0.f, 0.f, 0.f, 0.f};
        f16x8_ bq[5], b1[5], b2[5];
#pragma unroll
        for (int f = 0; f < 5; ++f) { b1[f] = P5_LDB(0, f); b2[f] = P5_LDB(1, f); }
#pragma unroll
        for (int cg = 0; cg < 4; ++cg) {
            unsigned h8[4];
#pragma unroll
            for (int hh = 0; hh < 2; ++hh) {
                const int c = 2 * cg + hh;
#pragma unroll
                for (int f = 0; f < 5; ++f) { bq[f] = b1[f]; b1[f] = b2[f]; }
                if (c + 2 < 8) {
#pragma unroll
                    for (int f = 0; f < 5; ++f) b2[f] = P5_LDB(c + 2, f);
                }
                const f32x4 a2a = *(const LAS f32x4*)(pv + DM + ko + 64 * cg + 8 * hh), a2b = *(const LAS f32x4*)(pv + DM + ko + 64 * cg + 8 * hh + 4);
                const f32x4 a3a = *(const LAS f32x4*)(pv + 2 * DM + ko + 64 * cg + 8 * hh), a3b = *(const LAS f32x4*)(pv + 2 * DM + ko + 64 * cg + 8 * hh + 4);
                const f32x4 ha = xv[cg][2 * hh] * r1 * a2a + a3a, hb = xv[cg][2 * hh + 1] * r1 * a2b + a3b;
                h8[2 * hh] = pk4_fp8(ha.x * SC_H, ha.y * SC_H, ha.z * SC_H, ha.w * SC_H); h8[2 * hh + 1] = pk4_fp8(hb.x * SC_H, hb.y * SC_H, hb.z * SC_H, hb.w * SC_H);
                const unsigned h0 = pkh2(ha.x, ha.y), h1 = pkh2(ha.z, ha.w), h2 = pkh2(hb.x, hb.y), h3 = pkh2(hb.z, hb.w);
                const unsigned l0 = pkh2(ha.x - h_lo(h0), ha.y - h_hi(h0)), l1 = pkh2(ha.z - h_lo(h1), ha.w - h_hi(h1)), l2 = pkh2(hb.x - h_lo(h2), hb.y - h_hi(h2)), l3 = pkh2(hb.z - h_lo(h3), hb.w - h_hi(h3));
                const f16x8_ ahi = __builtin_bit_cast(f16x8_, (v4u){h0, h1, h2, h3}), alo = __builtin_bit_cast(f16x8_, (v4u){l0, l1, l2, l3});
#pragma unroll
                for (int nf = 0; nf < 5; ++nf) { acc[nf] = __builtin_amdgcn_mfma_f32_16x16x32_f16(ahi, bq[nf], acc[nf], 0, 0, 0); acc[nf] = __builtin_amdgcn_mfma_f32_16x16x32_f16(alo, bq[nf], acc[nf], 0, 0, 0); }
            }
            *(v4u*)(hrow + 64 * cg) = (v4u){h8[0], h8[1], h8[2], h8[3]};
        }
#undef P5_LDB
#pragma unroll
        for (int nf = 0; nf < 5; ++nf)
#pragma unroll
            for (int ii = 0; ii < 4; ++ii) part[(w * 16 + 4 * q + ii) * 80 + 16 * nf + r] = acc[nf][ii];
        P5_BAR();
        for (int p = F.tid; p < 16 * 80; p += NWAVES * 64) { const int tok = p / 80, n = p - tok * 80; float sum = 0.f;
#pragma unroll
            for (int ww = 0; ww < 8; ++ww) sum += part[(ww * 16 + tok) * 80 + n];
            lg[p] = sum; }
        P5_BAR();
        if (F.tid < 16) {
            const LAS float* L = lg + F.tid * 80;
            float ac[8];
#pragma unroll
            for (int n = 0; n < 8; ++n) ac[n] = L[n] + A.b_rg()[n];
            int g = 0; float mx = ac[0];
#pragma unroll
            for (int n = 1; n < 8; ++n) if (ac[n] > mx) { mx = ac[n]; g = n; }
            float se = 0.f;
#pragma unroll
            for (int n = 0; n < 8; ++n) se += expf(ac[n] - mx);
            const float pg = 1.0f / se;
            float af[8];
#pragma unroll
            for (int n = 0; n < 8; ++n) af[n] = L[8 + 8 * g + n] + A.b_re()[g * 8 + n];
            int i0 = 0; float v0 = af[0];
#pragma unroll
            for (int n = 1; n < 8; ++n) if (af[n] > v0) { v0 = af[n]; i0 = n; }
            int i1 = -1; float v1 = 0.f;
#pragma unroll
            for (int n = 0; n < 8; ++n) if (n != i0 && (i1 < 0 || af[n] > v1)) { v1 = af[n]; i1 = n; }
            const float ee = expf(v1 - v0), w0 = 1.0f / (1.0f + ee), w1 = ee / (1.0f + ee);
            const int e0 = g * 8 + i0, e1 = g * 8 + i1, mm = mt0 + F.tid, ix = nrec + 2 * F.tid;
            rec_e[ix] = e0; rec_a[ix] = 2 * mm; rec_w[ix] = pg * w0; rec_p[ix] = __hip_atomic_fetch_add(lcnt + e0, 1, __ATOMIC_RELAXED, __HIP_MEMORY_SCOPE_WORKGROUP);
            rec_e[ix + 1] = e1; rec_a[ix + 1] = 2 * mm + 1; rec_w[ix + 1] = pg * w1; rec_p[ix + 1] = __hip_atomic_fetch_add(lcnt + e1, 1, __ATOMIC_RELAXED, __HIP_MEMORY_SCOPE_WORKGROUP);
        }
        nrec += 32;
    }
    P5_BAR();
    if (F.tid < 64) { const int n = lcnt[F.tid]; lbase[F.tid] = n > 0 ? (int)__hip_atomic_fetch_add(A.ctl() + CW_CNT + 64 * F.tid, (unsigned)n, RLX_AGENT) : 0; }
    P5_BAR();
    for (int ix = F.tid; ix < nrec; ix += NWAVES * 64) { const int e = rec_e[ix], slot = lbase[e] + rec_p[ix];
        A.lista()[(size_t)e * LISTCAP + slot] = (int)((unsigned)rec_a[ix] | (cvt2bf(0.f, rec_w[ix]) & 0xffff0000u)); }
}
#undef P5_BAR

struct MUnit { int e, mt, nt, cnt, prow, half; };
constexpr int MOE_MAXU = 24;
__device__ __forceinline__ void moe_tables(const Frame& F, const Args& A) {
    LAS int* T = (LAS int*)(F.lds + TAB_OFF);
    if (F.tid < 64) {
        const int c = (int)__hip_atomic_load(A.ctl() + CW_CNT + 64 * F.tid, RLX_AGENT), full = c >> 8, rem = c & 255;
        int rows = ((c + 255) >> 8) << 8, ua = (full + (rem > 128 ? 1 : 0)) * 8, ub = (rem > 0 && rem <= 128) ? 8 : 0;
        const int rows0 = rows, ua0 = ua, ub0 = ub;
#pragma unroll
        for (int o = 1; o < 64; o <<= 1) { const int r1 = __shfl_up(rows, o), a1 = __shfl_up(ua, o), b1 = __shfl_up(ub, o); if (F.lane >= o) { rows += r1; ua += a1; ub += b1; } }
        T[F.tid] = c; T[64 + F.tid] = rows - rows0; T[128 + F.tid] = ua - ua0; T[200 + F.tid] = ub - ub0;
        if (F.tid == 63) { T[128 + 64] = ua; T[200 + 64] = ub; } }
    __syncthreads();
    const int G = F.G, bx = (int)blockIdx.x, rk = (G % 8 == 0) ? (bx % 8) * (G / 8) + bx / 8 : bx;
    const int UA = T[192], UB = T[264], nu = (UA + UB > rk) ? (UA + UB - rk + G - 1) / G : 0;
    if (F.tid == 0) T[270] = nu < MOE_MAXU ? nu : MOE_MAXU;
    if (F.tid < MOE_MAXU && F.tid < nu) {
        const int p = F.tid * G + rk; int e = 0, mt, nt, half;
        if (p < UA) { for (int q = 1; q < NEXP; ++q) if (p >= T[128 + q]) e = q; const int l = p - T[128 + e]; mt = l >> 3; nt = l & 7; half = 0; }
        else { const int pp = p - UA; for (int q = 1; q < NEXP; ++q) if (pp >= T[200 + q]) e = q; mt = T[e] >> 8; nt = (pp - T[200 + e]) & 7; half = 1; }
        LAS int* d = T + 272 + 4 * F.tid; d[0] = e; d[1] = mt; d[2] = nt; d[3] = half; }
    __syncthreads();
}
struct MoeSched {
    const LAS int* T;
    __device__ __forceinline__ bool next(int i, MUnit& u) const {
        if (i >= T[270]) return false;
        const LAS int* d = T + 272 + 4 * i; const int e = d[0], mt = d[1];
        u.e = __builtin_amdgcn_readfirstlane(e); u.mt = __builtin_amdgcn_readfirstlane(mt); u.nt = __builtin_amdgcn_readfirstlane(d[2]); u.half = __builtin_amdgcn_readfirstlane(d[3]);
        u.cnt = __builtin_amdgcn_readfirstlane(T[e]); u.prow = __builtin_amdgcn_readfirstlane(T[64 + e] + 256 * mt); return true;
    }
};
typedef int v4i_ __attribute__((ext_vector_type(4)));
typedef int v8i_ __attribute__((ext_vector_type(8)));
struct EpiGateUp8 {
    static constexpr bool HAS_PRE = false;
    unsigned char* HID;
    __device__ __forceinline__ void pre(const MUnit&, int, int, int (&)[8]) const {}
    __device__ __forceinline__ void operator()(const pg8::f32x4 (&acc)[2][2][4][2], const MUnit& u, int wr, int wc, int fr, int fq, const int (&)[8]) const {
        unsigned char* tile = HID + ((size_t)(u.prow >> 8) * 8 + u.nt) * 32768; const int rowt = wr * 64 + fr, colt = wc * 32 + 8 * fq; const float sc = 1.0f / (SC_H * SC_WGU);
#pragma unroll
        for (int ai = 0; ai < 2; ++ai) { if (ai == 1 && u.half) break;
#pragma unroll
            for (int m = 0; m < 4; ++m) { unsigned char* rowp = tile + (size_t)(rowt + ai * 128 + m * 16) * 128 + colt;
                pg8::f32x4 a0 = acc[ai][0][m][0] * sc, a1 = acc[ai][0][m][1] * sc; const pg8::f32x4 b0 = acc[ai][1][m][0] * (sc * SC_HID), b1 = acc[ai][1][m][1] * (sc * SC_HID);
#pragma unroll
                for (int i = 0; i < 4; ++i) { a0[i] = a0[i] * sigmoidf_(a0[i]) * b0[i]; a1[i] = a1[i] * sigmoidf_(a1[i]) * b1[i]; }
                *(v2u*)rowp = (v2u){pk4_fp8(a0[0], a0[1], a0[2], a0[3]), pk4_fp8(a1[0], a1[1], a1[2], a1[3])}; } }
    }
};
struct EpiDown8 {
    static constexpr bool HAS_PRE = true;
    bf16* YD; const int* lrec;
    __device__ __forceinline__ void pre(const MUnit& u, int wr, int fr, int (&pa)[8]) const {
#pragma unroll
        for (int ai = 0; ai < 2; ++ai)
#pragma unroll
            for (int m = 0; m < 4; ++m) { const int s = 256 * u.mt + ai * 128 + wr * 64 + m * 16 + fr; const int sc = s < u.cnt ? s : 0;
                pa[ai * 4 + m] = lrec[(size_t)u.e * LISTCAP + sc]; }
    }
    __device__ __forceinline__ void operator()(const pg8::f32x4 (&acc)[2][2][4][2], const MUnit& u, int wr, int wc, int fr, int fq, const int (&pa)[8]) const {
        const int col0 = u.nt * 256 + wc * 32 + 8 * fq;
#pragma unroll
        for (int ai = 0; ai < 2; ++ai)
#pragma unroll
            for (int m = 0; m < 4; ++m) { const int s = 256 * u.mt + ai * 128 + wr * 64 + m * 16 + fr;
                if (s < u.cnt) { const unsigned rc = (unsigned)pa[ai * 4 + m]; const int a = (int)(rc & 0xffffu); const float wgt = bf_hi(rc) * (1.0f / (SC_HID * SC_WD));
                    bf16* rowp = YD + (size_t)a * DM + col0;
#pragma unroll
                    for (int bj = 0; bj < 2; ++bj) { const pg8::f32x4 v0 = acc[ai][bj][m][0] * wgt, v1 = acc[ai][bj][m][1] * wgt;
                        v4u w; w.x = pg8::cvt_pk_bf16(v0[0], v0[1]); w.y = pg8::cvt_pk_bf16(v0[2], v0[3]); w.z = pg8::cvt_pk_bf16(v1[0], v1[1]); w.w = pg8::cvt_pk_bf16(v1[2], v1[3]);
                        *(v4u*)(rowp + bj * 128) = w; } } }
    }
};

template <class Epi, bool GATHER>
__device__ __forceinline__ void gemm_phase_moe8(LAS unsigned char* lds, const unsigned char* Abase, const unsigned char* Wbase, const int KB, const int* lista, const MoeSched& S, const Epi& E, const int wave_id) {
    using namespace pg8;
    int tid_ = wave_id * 64 + lane_id_fresh();
    const int tid = tid_, wid = __builtin_amdgcn_readfirstlane(tid >> 6), lane = tid & 63, wr = wid >> 2, wc = wid & 3, fr = lane & 15, fq = lane >> 4;
    const int nt = KB / 128;
    int Rr[2], Cc[2]; unsigned voffB[2];
#pragma unroll
    for (int i = 0; i < 2; ++i) { int R, C; stage_rc(tid * 16 + i * 8192, R, C); const int Rb = (R & ~31) + perm32(R & 31); Rr[i] = R; Cc[i] = C; voffB[i] = (unsigned)(Rb * 128 + C * 2); }
    const size_t kstep = GATHER ? 128 : 32768;
    const size_t kstepB = (size_t)2048 * 128, hstep = (size_t)HALF * 128;
    const unsigned ldsw = (unsigned)wid * 1024u;
    const int aoff = lds_byte(wr * 64 + fr, fq * 8), boff = lds_byte(wc * 32 + fr, fq * 8);
#define PG8_SA(b, h) (((b) * 2 + (h)) * HTB)
#define PG8_SB(b, h) ((4 + (b) * 2 + (h)) * HTB)
#define PG8_STAGE(bufoff, gbase, voff) do { _Pragma("unroll") for (int _i = 0; _i < 2; ++_i) { const char* _gb = uniform_ptr((const char*)(gbase)); asm volatile("" : "+s"(_gb));     \
        __builtin_amdgcn_global_load_lds((const unsigned*)(_gb + (voff)[_i]), (PG8_LAS unsigned*)(lds + (bufoff) + ldsw + _i * 8192), 16, 0, 0); } } while (0)
#define PG8_STAGE2(bufoff, gbase, o0, o1) do { const char* _g0 = uniform_ptr((const char*)(gbase)); const char* _g1 = _g0; asm volatile("" : "+s"(_g0), "+s"(_g1)); \
        __builtin_amdgcn_global_load_lds((const unsigned*)(_g0 + (o0)), (PG8_LAS unsigned*)(lds + (bufoff) + ldsw), 16, 0, 0); \
        __builtin_amdgcn_global_load_lds((const unsigned*)(_g1 + (o1)), (PG8_LAS unsigned*)(lds + (bufoff) + ldsw + 8192), 16, 0, 0); } while (0)
#define PG8_LDA(dst, b, h) do { _Pragma("unroll") for (int m = 0; m < 4; ++m) dst[m] = PG8_CAT(*(const PG8_LAS v4i_*)(lds + PG8_SA(b, h) + aoff + m * 2048), *(const PG8_LAS v4i_*)(lds + PG8_SA(b, h) + aoff + m * 2048 + 1024)); } while (0)
#define PG8_LDB(dst, b, h) do { _Pragma("unroll") for (int n = 0; n < 2; ++n) dst[n] = PG8_CAT(*(const PG8_LAS v4i_*)(lds + PG8_SB(b, h) + boff + n * 2048), *(const PG8_LAS v4i_*)(lds + PG8_SB(b, h) + boff + n * 2048 + 1024)); } while (0)
#define PG8_MMA(ai, bj, At, Bt) do { __builtin_amdgcn_s_setprio(1); _Pragma("unroll") for (int m = 0; m < 4; ++m) _Pragma("unroll") for (int n = 0; n < 2; ++n) \
        asm volatile("v_mfma_f32_16x16x128_f8f6f4 %0, %1, %2, %0" : "+v"(acc[ai][bj][m][n]) : "v"(Bt[n]), "v"(At[m])); __builtin_amdgcn_s_setprio(0); } while (0)
#define PG8_MFMA_DRAIN() asm volatile("s_nop 15\n\ts_nop 15" ::: "memory")
#define PG8_CAT(x, y) __builtin_shufflevector((x), (y), 0, 1, 2, 3, 4, 5, 6, 7)
#define PG8_WAIT_V(n) asm volatile("s_waitcnt vmcnt(" #n ")" ::: "memory")
#define PG8_WAIT_L(n) asm volatile("s_waitcnt lgkmcnt(" #n ")" ::: "memory")
#define PG8_BAR __builtin_amdgcn_s_barrier()
#define PG8_SCHED __builtin_amdgcn_sched_barrier(0)
#define MOE_ROWOFF(dst, u, h, i) do { const int _s = 256 * (u).mt + 128 * (h) + Rr[i]; \
        if (GATHER) { int _tok = 0; if (_s < (u).cnt) _tok = (lista[(size_t)(u).e * LISTCAP + _s] & 0xffff) >> 1; dst = (unsigned)_tok * (unsigned)KB + (unsigned)(Cc[i] * 2); } \
        else dst = (unsigned)((u).prow >> 8) * (unsigned)(KB * 256) + (unsigned)(128 * (h) + Rr[i]) * 128u + (unsigned)(Cc[i] * 2); } while (0)
    MUnit cur, nxt; int ui = 0;
    if (!S.next(0, cur)) return;
    f32x4 acc[2][2][4][2];
#pragma unroll
    for (int a = 0; a < 2; ++a)
#pragma unroll
        for (int b = 0; b < 2; ++b)
#pragma unroll
            for (int m = 0; m < 4; ++m)
#pragma unroll
                for (int n = 0; n < 2; ++n) acc[a][b][m][n] = (f32x4){0.f, 0.f, 0.f, 0.f};
    v8i_ At[4], B0[2], B1[2];
    unsigned c00, c01, c10, c11, n00, n01, n10, n11;
    MOE_ROWOFF(c00, cur, 0, 0); MOE_ROWOFF(c01, cur, 0, 1); MOE_ROWOFF(c10, cur, 1, 0); MOE_ROWOFF(c11, cur, 1, 1);
    const char* const cA = (const char*)Abase;
    const char* cB = (const char*)Wbase + (size_t)cur.e * 2048 * KB + (size_t)cur.nt * 32768;
    PG8_STAGE(PG8_SB(0, 0), cB, voffB); PG8_STAGE(PG8_SB(0, 1), cB + hstep, voffB); PG8_STAGE2(PG8_SA(0, 0), cA, c00, c01); PG8_STAGE2(PG8_SA(0, 1), cA, c10, c11);
    if (wr == 1) PG8_BAR;
    PG8_WAIT_V(2); PG8_BAR;
    PG8_STAGE(PG8_SB(1, 0), cB + kstepB, voffB); PG8_STAGE2(PG8_SA(1, 0), cA + kstep, c00, c01); PG8_STAGE(PG8_SB(1, 1), cB + hstep + kstepB, voffB);
    PG8_WAIT_V(6); PG8_BAR;
    for (;;) {
        const bool has_next = S.next(ui + 1, nxt);
        const char* nB = cB;
        n00 = c00; n01 = c01; n10 = c10; n11 = c11;
        if (has_next) { MOE_ROWOFF(n00, nxt, 0, 0); MOE_ROWOFF(n01, nxt, 0, 1); MOE_ROWOFF(n10, nxt, 1, 0); MOE_ROWOFF(n11, nxt, 1, 1);
            nB = (const char*)Wbase + (size_t)nxt.e * 2048 * KB + (size_t)nxt.nt * 32768; }
        int pa[8];
        const bool chalf = cur.half != 0;
        for (int t = 0; t < nt; t += 2) {
            const bool last = (t == nt - 2);
            const char* a1 = cA + (size_t)(t + 1) * kstep;
            const char* a2 = last ? cA : cA + (size_t)(t + 2) * kstep; const char* b2 = last ? nB : cB + (size_t)(t + 2) * kstepB;
            const char* a3 = a2 + kstep; const char* b3 = b2 + kstepB;
            unsigned x00 = c00, x01 = c01, x10 = c10, x11 = c11;
            if (last) { if (Epi::HAS_PRE) E.pre(cur, wr, fr, pa);
                asm volatile("" : "+v"(n00), "+v"(n01), "+v"(n10), "+v"(n11));
                x00 = n00; x01 = n01; x10 = n10; x11 = n11; }
            PG8_LDB(B0, 0, 0); PG8_LDB(B1, 0, 1); PG8_SCHED; PG8_LDA(At, 0, 0); PG8_STAGE2(PG8_SA(1, 1), a1, c10, c11);
            PG8_WAIT_V(8); PG8_WAIT_L(0); PG8_BAR; PG8_MMA(0, 0, At, B0); PG8_MMA(0, 1, At, B1); PG8_BAR; PG8_SCHED;
            if (!chalf) PG8_LDA(At, 0, 1);
            PG8_STAGE(PG8_SB(0, 0), b2, voffB); PG8_STAGE(PG8_SB(0, 1), b2 + hstep, voffB); PG8_STAGE2(PG8_SA(0, 0), a2, x00, x01);
            PG8_WAIT_V(8); PG8_WAIT_L(0); PG8_BAR; if (!chalf) { PG8_MMA(1, 0, At, B0); PG8_MMA(1, 1, At, B1); } PG8_BAR; PG8_SCHED;
            PG8_LDB(B0, 1, 0); PG8_LDB(B1, 1, 1); PG8_SCHED; PG8_LDA(At, 1, 0); PG8_STAGE2(PG8_SA(0, 1), a2, x10, x11);
            PG8_WAIT_V(8); PG8_WAIT_L(0); PG8_BAR; PG8_MMA(0, 0, At, B0); PG8_MMA(0, 1, At, B1); PG8_BAR; PG8_SCHED;
            if (!chalf) PG8_LDA(At, 1, 1);
            PG8_STAGE(PG8_SB(1, 0), b3, voffB); PG8_STAGE(PG8_SB(1, 1), b3 + hstep, voffB); PG8_STAGE2(PG8_SA(1, 0), a3, x00, x01);
            PG8_WAIT_V(8); PG8_WAIT_L(0); PG8_BAR; if (!chalf) { PG8_MMA(1, 0, At, B0); PG8_MMA(1, 1, At, B1); } PG8_BAR; PG8_SCHED;
        }
        if (wr == 0) PG8_BAR;
        PG8_MFMA_DRAIN();
        E(acc, cur, wr, wc, fr, fq, pa);
        if (!has_next) break;
#pragma unroll
        for (int a = 0; a < 2; ++a)
#pragma unroll
            for (int b = 0; b < 2; ++b)
#pragma unroll
                for (int m = 0; m < 4; ++m)
#pragma unroll
                    for (int n = 0; n < 2; ++n) acc[a][b][m][n] = (f32x4){0.f, 0.f, 0.f, 0.f};
        cur = nxt; cB = nB; c00 = n00; c01 = n01; c10 = n10; c11 = n11; ++ui;
        if (wr == 1) PG8_BAR;
    }
    PG8_WAIT_V(0);
    PG8_BAR;
#undef MOE_ROWOFF
#undef PG8_SA
#undef PG8_SB
#undef PG8_STAGE
#undef PG8_STAGE2
#undef PG8_LDA
#undef PG8_LDB
#undef PG8_MMA
#undef PG8_MFMA_DRAIN
#undef PG8_CAT
#undef PG8_WAIT_V
#undef PG8_WAIT_L
#undef PG8_BAR
#undef PG8_SCHED
}

__device__ __forceinline__ void p8_row_load(const Args& A, int m, int lane, f32x4 (&xv)[8], f32x4 (&yv)[8]) {
    const v2u* xr = (const v2u*)(A.X1() + (size_t)m * DM) + lane;
    const v2u* y0 = (const v2u*)(A.YD() + (size_t)(2 * m) * DM) + lane;
    const v2u* y1 = (const v2u*)(A.YD() + (size_t)(2 * m + 1) * DM) + lane;
#pragma unroll
    for (int j = 0; j < 8; ++j) { const v2u xx = xr[64 * j]; xv[j] = (f32x4){bf_lo(xx.x), bf_hi(xx.x), bf_lo(xx.y), bf_hi(xx.y)}; const v2u p = y0[64 * j], q = y1[64 * j];
        yv[j] = (f32x4){bf_lo(p.x) + bf_lo(q.x), bf_hi(p.x) + bf_hi(q.x), bf_lo(p.y) + bf_lo(q.y), bf_hi(p.y) + bf_hi(q.y)}; }
}
__device__ __forceinline__ void p8_row_finish(const Args& A, int m, int lane, const f32x4 (&xv)[8], const f32x4 (&yv)[8], const f32x4 (&gg)[8]) {
    float s = 0.f;
#pragma unroll
    for (int j = 0; j < 8; ++j) s += dot4(yv[j], yv[j]);
    const float r = 1.0f / sqrtf(wave_sum(s) * (1.0f / DM) + EPS);
    f32x4* outr = (f32x4*)(A.out() + (size_t)m * DM) + lane;
#pragma unroll
    for (int j = 0; j < 8; ++j) outr[64 * j] = xv[j] + gg[j] * (yv[j] * r);
}
__device__ __forceinline__ void p8_final(const Frame& F, const Args& A) {
    const int gw = F.vcu * NWAVES + F.wave, NGW = F.G * NWAVES, lane = F.lane;
    f32x4 gg[8]; int bcur = -1;
    for (int m0 = gw; m0 < NTOK; m0 += 2 * NGW) {
        const int m1 = m0 + NGW; const bool has1 = (m1 < NTOK) && ((m1 >> 14) == (m0 >> 14));
        f32x4 xa[8], ya[8], xb[8], yb[8];
        p8_row_load(A, m0, lane, xa, ya);
        p8_row_load(A, has1 ? m1 : m0, lane, xb, yb);
        if ((m0 >> 14) != bcur) { bcur = m0 >> 14; const f32x4* gp = (const f32x4*)A.g_post2() + lane; const f32x4* g2 = (const f32x4*)(A.mod() + bcur * NMODC + 5 * DM) + lane;
#pragma unroll
            for (int j = 0; j < 8; ++j) gg[j] = gp[64 * j] * g2[64 * j]; }
        p8_row_finish(A, m0, lane, xa, ya, gg);
        if (has1) p8_row_finish(A, m1, lane, xb, yb, gg);
        else if (m1 < NTOK) { m0 -= NGW; }
    }
}
#ifndef PHMASK
#define PHMASK 511
#endif
#ifndef GEMM2_SHARE
#define GEMM2_SHARE 27
#endif
#ifndef GEMM4_SHARE
#define GEMM4_SHARE 26
#endif
#ifndef REPMASK
#define REPMASK 0
#endif
#define REPS(k) (((REPMASK >> (k)) & 1) ? 2 : 1)

__global__ void __launch_bounds__(NWAVES * 64, 2) mk_fwd(Args args) {
    extern __shared__ __attribute__((aligned(16))) unsigned char lds[];
    Frame F;
    F.lds = (LAS unsigned char*)lds;
    F.tid = threadIdx.x; F.lane = F.tid & 63; F.wave = __builtin_amdgcn_readfirstlane(F.tid >> 6);
    F.G = gridDim.x; { const int bx = blockIdx.x; F.vcu = (F.G % 8 == 0) ? (bx % 8) * (F.G / 8) + bx / 8 : bx; }
    const Args& A = args;
    for (int u = F.tid; u < (LDS_BYTES - LDSCTL_OFF) / 4; u += NWAVES * 64) ((LAS unsigned*)(F.lds + LDSCTL_OFF))[u] = 0u;
    __syncthreads();
#ifdef TLSEL
    unsigned tl_acc = 0;
#define TL_NOW() ((unsigned)__builtin_amdgcn_s_memrealtime())
#define TL_AT(sel, ...) do { if (TLSEL == (sel)) { __VA_ARGS__; } } while (0)
#else
#define TL_AT(sel, ...) do {} while (0)
#endif
    XcdBarrier bar = xcd_barrier_post(A.ctl() + CW_BAR, (volatile LAS unsigned*)(F.lds + LDSCTL_OFF));

#if PHMASK & 1
    p0_ada(phase_frame(F), A); p0_router_weights(phase_frame(F), A); p0_weights(phase_frame(F), A);
#ifdef ISO_CONV
    __syncthreads(); if ((int)blockIdx.x >= ISO_CONV) expert_worker(phase_frame(F), A, 0u);
#endif
    if (REPS(0) == 2) { __syncthreads(); p0_ada(phase_frame(F), A); p0_weights(phase_frame(F), A); }
#endif
    xcd_barrier(bar, F.wave);
#if PHMASK & 2
    p1_norm1(phase_frame(F), A);
    if (REPS(1) == 2) p1_norm1(phase_frame(F), A);
#endif
    xcd_barrier(bar, F.wave);
#if PHMASK & 4
    {
        const int NG2 = (F.G % 8 == 0 && F.G >= 64) ? (F.G / 8 * GEMM2_SHARE / 32) * 8 : F.G;
        TL_AT(10, tl_acc -= TL_NOW()); TL_AT(13, tl_acc -= TL_NOW());
        if ((int)blockIdx.x < NG2) {
            pg8::Gemm g{A.H(), A.WIN(), NTOK, DINP, DM}; pg8::StaticOrder S; S.init(NTOK, DINP, NG2, (int)blockIdx.x);
            EpiInProj E{A.P()};
            pg8::gemm_phase<EpiInProj, pg8::StaticOrder, true, true>(F.lds + RING_OFF, g, S, E, F.wave);
            if (threadIdx.x == 0) __hip_atomic_fetch_add(A.ctl() + CW_DONE, 1u, RLX_AGENT);
        }
        TL_AT(13, tl_acc += TL_NOW());
        expert_worker(phase_frame(F), A, (unsigned)NG2);
        TL_AT(10, tl_acc += TL_NOW()); }
    if (REPS(2) == 2) {   pg8::Gemm g{A.H(), A.WIN(), NTOK, DINP, DM}; pg8::StaticOrder S; S.init(NTOK, DINP, F.G, (int)blockIdx.x);
        EpiInProj E{A.P()};
        pg8::gemm_phase<EpiInProj, pg8::StaticOrder, true, true>(F.lds + RING_OFF, g, S, E, F.wave); }
#endif
    xcd_barrier(bar, F.wave);
    TL_AT(12, { unsigned q = __hip_atomic_load(A.ctl() + CW_Q, RLX_AGENT); tl_acc = q < 12288u ? q : 12288u; });
#if PHMASK & 8
    p3_mix(phase_frame(F), A);
    if (REPS(3) == 2) p3_mix(phase_frame(F), A);
#endif
    xcd_barrier(bar, F.wave);
#if PHMASK & 16
    {
        const int NG2 = (F.G % 8 == 0 && F.G >= 64) ? (F.G / 8 * GEMM2_SHARE / 32) * 8 : F.G;
        const int NG4 = (F.G % 8 == 0 && F.G >= 64) ? (F.G / 8 * GEMM4_SHARE / 32) * 8 : F.G;
        if ((int)blockIdx.x < NG4) {
            pg8::Gemm g{A.Y(), A.WOUT(), NTOK, DM, DM}; pg8::StaticOrder S; S.init(NTOK, DM, NG4, (int)blockIdx.x);
            EpiStoreFrag E{A.O(), DM / 256};
            pg8::gemm_phase<EpiStoreFrag, pg8::StaticOrder, true, true>(F.lds + RING_OFF, g, S, E, F.wave);
            if (threadIdx.x == 0) __hip_atomic_fetch_add(A.ctl() + CW_DONE, 1u, RLX_AGENT);
        }
        expert_worker(phase_frame(F), A, (unsigned)(NG2 + NG4)); }
    if (REPS(4) == 2) {   pg8::Gemm g{A.Y(), A.WOUT(), NTOK, DM, DM}; pg8::StaticOrder S; S.init(NTOK, DM, F.G, (int)blockIdx.x);
        EpiStoreFrag E{A.O(), DM / 256};
        pg8::gemm_phase<EpiStoreFrag, pg8::StaticOrder, true, true>(F.lds + RING_OFF, g, S, E, F.wave); }
#endif
    xcd_barrier(bar, F.wave);
#if PHMASK & 32
    p5_norm2_router(phase_frame(F), A);
    __syncthreads();
    TL_AT(11, tl_acc -= TL_NOW());
    expert_worker(phase_frame(F), A, 0u);
    TL_AT(11, tl_acc += TL_NOW());
#endif
    xcd_barrier(bar, F.wave);
    moe_tables(phase_frame(F), A);
    MoeSched MS; MS.T = (const LAS int*)(F.lds + TAB_OFF);
#if PHMASK & 64
#ifdef REP6LOOP
    for (int rep = 0; rep < 2; ++rep)
#endif
    {   EpiGateUp8 E{A.HID()};
        gemm_phase_moe8<EpiGateUp8, true>(F.lds + RING_OFF, A.H8(), A.WGU(), DM, A.lista(), MS, E, F.wave); }
#endif
    xcd_barrier(bar, F.wave);
#if PHMASK & 128
#ifdef REP7LOOP
    for (int rep = 0; rep < 2; ++rep)
#endif
    {   EpiDown8 E{A.YD(), A.lista()};
        gemm_phase_moe8<EpiDown8, false>(F.lds + RING_OFF, A.HID(), A.WD(), DEXP, A.lista(), MS, E, F.wave); }
#endif
    xcd_barrier(bar, F.wave);
#if PHMASK & 256
    p8_final(phase_frame(F), A);
#endif
#ifdef TLSEL
    if (blockIdx.x == 0 && F.wave == 0) { const unsigned long long t0 = __builtin_amdgcn_s_memrealtime(), w = (unsigned long long)tl_acc * TLMUL;
        while (__builtin_amdgcn_s_memrealtime() - t0 < w) __builtin_amdgcn_s_sleep(8); }
#endif
}

extern "C" void kernel_launch(void* const* d_in, const int* in_sizes, int n_in, void* d_out, int out_size, void* d_ws, size_t ws_size, hipStream_t stream) {
    static int grid = 0;
    if (grid == 0) {
        if (n_in != 23 || in_sizes[0] != NTOK * DM || out_size != NTOK * DM || ws_size < WS_END) { fprintf(stderr, "kernel_launch: unexpected shapes (n_in %d, in0 %d, out %d, ws %zu)\n", n_in, n_in > 0 ? in_sizes[0] : -1, out_size, ws_size); grid = -1; return; }
        int dev = 0, cus = 0, per_cu = 0;
        if (hipGetDevice(&dev) != hipSuccess || hipDeviceGetAttribute(&cus, hipDeviceAttributeMultiprocessorCount, dev) != hipSuccess) { grid = -1; return; }
        if (hipFuncSetAttribute((const void*)mk_fwd, hipFuncAttributeMaxDynamicSharedMemorySize, LDS_BYTES) != hipSuccess) { fprintf(stderr, "kernel_launch: hipFuncSetAttribute failed\n"); grid = -1; return; }
        if (hipOccupancyMaxActiveBlocksPerMultiprocessor(&per_cu, (const void*)mk_fwd, NWAVES * 64, LDS_BYTES) != hipSuccess || per_cu < 1) { fprintf(stderr, "kernel_launch: occupancy query says %d\n", per_cu); }
        (void)hipGetLastError();
        grid = cus;
    }
    if (grid < 0) return;
    if (hipMemsetAsync((char*)d_ws + WS_CTL, 0, CTL_ZERO_BYTES, stream) != hipSuccess) return;
    Args a{};
    for (int i = 0; i < 23; ++i) a.in[i] = (const float*)d_in[i];
    a.out_ = (float*)d_out; a.ws = (unsigned char*)d_ws;
    hipLaunchKernelGGL(mk_fwd, dim3(grid), dim3(NWAVES * 64), LDS_BYTES, stream, a);
}
```
